# Optimizing an MI355X kernel written in HIP

```python
import jax, jax.numpy as jnp
from jax import lax
import numpy as np

D_MODEL = 2048
BATCH = 4
SEQ = 4096
DEPTH = 4

D_MIX = D_MODEL
RET_HEAD_DIM = D_MODEL // 16
RET_HEADS = 6
RET_WIDTH = RET_HEADS * RET_HEAD_DIM
RET_CHUNK = 128
ROPE_BASE = 10000.0
POOL_WINDOWS = (2, 4, 8, 16)
POOL_GROUPS = 4
POOL_GROUP_DIM = D_MODEL // 16
POOL_WIDTH = POOL_GROUPS * POOL_GROUP_DIM
GLA_HEADS = 4
GLA_WIDTH = D_MIX - RET_WIDTH - POOL_WIDTH
GLA_V_DIM = GLA_WIDTH // GLA_HEADS
GLA_K_DIM = GLA_V_DIM // 2
GLA_KEY_WIDTH = GLA_HEADS * GLA_K_DIM
GLA_GATE_RANK = 16
GLA_GATE_TAU = 16.0
GLA_CHUNK = 64
IN_WIDTH = 4 * RET_WIDTH + POOL_WIDTH + 2 * GLA_KEY_WIDTH + 2 * GLA_WIDTH + GLA_GATE_RANK
D_FF = 4 * D_MODEL
N_MOD = 6
EPS = 1e-6

kernel_name = "hybrid_retention_pool_gla_block"


def rms_norm(x, g):
    xf = x.astype(jnp.float32)
    y = xf * lax.rsqrt(jnp.mean(jnp.square(xf), axis=-1, keepdims=True) + EPS)
    return (y * g.astype(jnp.float32)).astype(x.dtype)


def head_layer_norm(o):
    mu = jnp.mean(o, axis=-1, keepdims=True)
    var = jnp.mean(jnp.square(o - mu), axis=-1, keepdims=True)
    return (o - mu) * lax.rsqrt(var + EPS)


def head_rms_norm(o):
    return o * lax.rsqrt(jnp.mean(jnp.square(o), axis=-1, keepdims=True) + EPS)


def rotary(x, cos, sin):
    x1, x2 = jnp.split(x, 2, axis=-1)
    c = cos[None, :, None, :]
    s = sin[None, :, None, :]
    return jnp.concatenate([x1 * c - x2 * s, x1 * s + x2 * c], axis=-1)


def retention(q, k, v):
    B, S, H, Dh = q.shape
    C = RET_CHUNK
    N = S // C
    log_g = jnp.log1p(-jnp.exp2(-5.0 - jnp.arange(H, dtype=jnp.float32)))
    q = q.reshape(B, N, C, H, Dh) * (Dh ** -0.5)
    k = k.reshape(B, N, C, H, Dh)
    v = v.reshape(B, N, C, H, Dh)
    idx = jnp.arange(C, dtype=jnp.float32)
    rel = idx[:, None] - idx[None, :]
    decay = jnp.where(rel[None] >= 0,
                      jnp.exp(jnp.maximum(rel, 0.0)[None] * log_g[:, None, None]), 0.0)
    scores = jnp.einsum('bnihd,bnjhd->bnhij', q, k) * decay
    inner = jnp.einsum('bnhij,bnjhe->bnihe', scores, v)
    zeta = jnp.exp((C - 1.0 - idx)[None, :] * log_g[:, None])
    u = jnp.einsum('bnjhd,hj,bnjhe->nbhde', k, zeta, v)
    g_chunk = jnp.exp(C * log_g)[None, :, None, None]

    def step(state, u_n):
        return g_chunk * state + u_n, state

    _, r_prev = lax.scan(step, jnp.zeros((B, H, Dh, Dh), jnp.float32), u)
    xi = jnp.exp((idx + 1.0)[None, :] * log_g[:, None])
    cross = jnp.einsum('bnihd,hi,nbhde->bnihe', q, xi, r_prev)
    return (inner + cross).reshape(B, S, H, Dh)


def gated_linear_attention(q, k, v, log_a):
    B, S, H, Dk = q.shape
    Dv = v.shape[-1]
    C = GLA_CHUNK
    N = S // C
    q = q.reshape(B, N, C, H, Dk) * (Dk ** -0.5)
    k = k.reshape(B, N, C, H, Dk)
    v = v.reshape(B, N, C, H, Dv)
    b = jnp.cumsum(log_a.reshape(B, N, C, H, Dk), axis=2)
    b_last = b[:, :, -1:]
    q_dec = q * jnp.exp(b)
    k_inv = k * jnp.exp(-b)
    causal = jnp.tril(jnp.ones((C, C), dtype=bool))
    scores = jnp.where(causal, jnp.einsum('bnihd,bnjhd->bnhij', q_dec, k_inv), 0.0)
    inner = jnp.einsum('bnhij,bnjhe->bnihe', scores, v)
    k_state = k * jnp.exp(b_last - b)
    u = jnp.einsum('bnjhd,bnjhe->nbhde', k_state, v)
    g_chunk = jnp.moveaxis(jnp.exp(b_last[:, :, 0]), 1, 0)[..., None]

    def step(state, inp):
        g_n, u_n = inp
        return g_n * state + u_n, state

    _, s_prev = lax.scan(step, jnp.zeros((B, H, Dk, Dv), jnp.float32), (g_chunk, u))
    cross = jnp.einsum('bnihd,nbhde->bnihe', q_dec, s_prev)
    return (inner + cross).reshape(B, S, H, Dv)


def multiscale_pool(u, w_pool, s_pool):
    B, S, _ = u.shape
    ug = u.reshape(B, S, POOL_GROUPS, POOL_GROUP_DIM)
    cs = jnp.concatenate([jnp.zeros((B, 1, POOL_GROUPS, POOL_GROUP_DIM), jnp.float32),
                          jnp.cumsum(ug, axis=1)], axis=1)
    t = jnp.arange(S)
    means = []
    for grp, w in enumerate(POOL_WINDOWS):
        lo = jnp.maximum(t + 1 - w, 0)
        win_sum = cs[:, 1:, grp] - jnp.take(cs[:, :, grp], lo, axis=1)
        cnt = (t + 1 - lo).astype(jnp.float32)
        means.append(win_sum / cnt[None, :, None])
    pooled = jnp.stack(means, axis=2) - ug
    y = jnp.einsum('bsgc,gcd->bsgd', pooled, w_pool.astype(jnp.float32))
    return y.reshape(B, S, POOL_WIDTH) * s_pool.astype(jnp.float32)


def hybrid_layer(x, c, w_ada, b_ada, g_mix, g_mlp, w_in, w_gate_up, b_gate,
                 w_pool, s_pool, w_out, w_up, w_down, cos, sin):
    B, S, _ = x.shape
    f32 = jnp.float32
    mod = jax.nn.silu(c) @ w_ada + b_ada
    sh1, sc1, gt1, sh2, sc2, gt2 = jnp.split(mod[:, None, :], N_MOD, axis=-1)

    h = rms_norm(x, g_mix) * (1.0 + sc1) + sh1
    z = h @ w_in
    sizes = [RET_WIDTH] * 4 + [POOL_WIDTH, GLA_KEY_WIDTH, GLA_KEY_WIDTH,
                               GLA_WIDTH, GLA_WIDTH, GLA_GATE_RANK]
    offsets = []
    acc = 0
    for sz in sizes[:-1]:
        acc += sz
        offsets.append(acc)
    (rq, rk, rv, rg, pu, gq, gk, gv, gr, gz) = jnp.split(z.astype(f32), offsets, axis=-1)

    rq = rotary(rq.reshape(B, S, RET_HEADS, RET_HEAD_DIM), cos, sin)
    rk = rotary(rk.reshape(B, S, RET_HEADS, RET_HEAD_DIM), cos, sin)
    ro = retention(rq, rk, rv.reshape(B, S, RET_HEADS, RET_HEAD_DIM))
    ret_out = head_layer_norm(ro).reshape(B, S, RET_WIDTH) * jax.nn.silu(rg)

    pool_out = multiscale_pool(pu, w_pool, s_pool)

    log_a = jax.nn.log_sigmoid(gz @ w_gate_up.astype(f32) + b_gate.astype(f32)) / GLA_GATE_TAU
    go = gated_linear_attention(gq.reshape(B, S, GLA_HEADS, GLA_K_DIM),
                                gk.reshape(B, S, GLA_HEADS, GLA_K_DIM),
                                gv.reshape(B, S, GLA_HEADS, GLA_V_DIM),
                                log_a.reshape(B, S, GLA_HEADS, GLA_K_DIM))
    gla_out = head_rms_norm(go).reshape(B, S, GLA_WIDTH) * jax.nn.silu(gr)

    mix = jnp.concatenate([ret_out, pool_out, gla_out], axis=-1).astype(x.dtype)
    x = x + gt1 * (mix @ w_out)

    h = rms_norm(x, g_mlp) * (1.0 + sc2) + sh2
    x = x + gt2 * (jnp.square(jax.nn.relu(h @ w_up)) @ w_down)
    return x


def setup_inputs(seed: int = 0) -> dict:
    key = jax.random.key(seed)
    ks = jax.random.split(key, 16)
    f32 = jnp.float32
    nrm = lambda k, shape, scale: jax.random.normal(k, shape, f32) * scale
    x = nrm(ks[0], (BATCH, SEQ, D_MODEL), 1.0)
    c = nrm(ks[1], (BATCH, D_MODEL), 1.0)
    w_ada = nrm(ks[2], (DEPTH, D_MODEL, N_MOD * D_MODEL), 0.5 * D_MODEL ** -0.5)
    b_ada = nrm(ks[3], (DEPTH, N_MOD * D_MODEL), 0.01)
    g_mix = 1.0 + nrm(ks[4], (DEPTH, D_MODEL), 0.05)
    g_mlp = 1.0 + nrm(ks[5], (DEPTH, D_MODEL), 0.05)
    w_in = nrm(ks[6], (DEPTH, D_MODEL, IN_WIDTH), D_MODEL ** -0.5)
    w_gate_up = nrm(ks[7], (DEPTH, GLA_GATE_RANK, GLA_KEY_WIDTH), GLA_GATE_RANK ** -0.5)
    b_gate = nrm(ks[8], (DEPTH, GLA_KEY_WIDTH), 0.1)
    w_pool = nrm(ks[9], (DEPTH, POOL_GROUPS, POOL_GROUP_DIM, POOL_GROUP_DIM), POOL_GROUP_DIM ** -0.5)
    s_pool = 1.0 + nrm(ks[10], (DEPTH, POOL_WIDTH), 0.1)
    w_out = nrm(ks[11], (DEPTH, D_MIX, D_MODEL), D_MIX ** -0.5)
    w_up = nrm(ks[12], (DEPTH, D_MODEL, D_FF), D_MODEL ** -0.5)
    w_down = nrm(ks[13], (DEPTH, D_FF, D_MODEL), D_FF ** -0.5)
    g_final = 1.0 + nrm(ks[14], (D_MODEL,), 0.05)
    return {"x": x, "c": c, "w_ada": w_ada, "b_ada": b_ada, "g_mix": g_mix,
            "g_mlp": g_mlp, "w_in": w_in, "w_gate_up": w_gate_up, "b_gate": b_gate,
            "w_pool": w_pool, "s_pool": s_pool, "w_out": w_out, "w_up": w_up,
            "w_down": w_down, "g_final": g_final}


def reference(x, c, w_ada, b_ada, g_mix, g_mlp, w_in, w_gate_up, b_gate,
              w_pool, s_pool, w_out, w_up, w_down, g_final):
    S = x.shape[1]
    pos = jnp.arange(S, dtype=jnp.float32)
    inv_freq = ROPE_BASE ** (-jnp.arange(0, RET_HEAD_DIM, 2, dtype=jnp.float32) / RET_HEAD_DIM)
    ang = pos[:, None] * inv_freq[None, :]
    cos, sin = jnp.cos(ang), jnp.sin(ang)
    for l in range(DEPTH):
        x = hybrid_layer(x, c, w_ada[l], b_ada[l], g_mix[l], g_mlp[l], w_in[l],
                         w_gate_up[l], b_gate[l], w_pool[l], s_pool[l], w_out[l],
                         w_up[l], w_down[l], cos, sin)
    return rms_norm(x, g_final)
```

```cpp
#include <hip/hip_runtime.h>
#include <cstdio>
#include <cstdint>
namespace pg8 {
#define PG8_LAS __attribute__((address_space(3)))
typedef unsigned short bf16_t;
typedef short bf16x8 __attribute__((ext_vector_type(8)));
typedef float f32x4 __attribute__((ext_vector_type(4)));
typedef unsigned u32x4 __attribute__((ext_vector_type(4)));
constexpr int BM = 256, BK = 64, HALF = 128, HTB = HALF * BK * 2  , STAGE_BYTES = 8 * HTB, NXCD = 8, WGM = 8;

__host__ __device__ __forceinline__ int lds_byte(int r, int c) { const int st = (r >> 4) * 2 + (c >> 5), rr = r & 15, cc = c & 31, ob = rr * 64 + cc * 2; return st * 1024 + (ob ^ (((ob >> 9) & 1) << 5)); }
__host__ __device__ __forceinline__ void stage_rc(int b, int& R, int& C) { const int st = b / 1024, sb = b % 1024, swz = sb ^ (((sb >> 9) & 1) << 5); R = (st >> 1) * 16 + swz / 64; C = (st & 1) * 32 + (swz % 64) / 2; }
__host__ __device__ __forceinline__ int perm32(int rho) { const int n = rho >> 4, i = rho & 15; return 8 * (i >> 2) + 4 * n + (i & 3); }

__host__ __device__ __forceinline__ size_t tiled_off(int row, int col, int K) { return ((size_t)(row >> 8) * (K >> 6) + (col >> 6)) * (BM * BK) + (size_t)((row & 255) * BK + (col & 63)); }
__host__ __device__ __forceinline__ size_t subtiled_off(int row, int col, int K) { const int r = row & 255, c = col & 63; return ((size_t)(row >> 8) * (K >> 6) + (col >> 6)) * (BM * BK) + (size_t)((((r >> 4) * 2 + (c >> 5)) << 9) + (r & 15) * 32 + (c & 31)); }
__host__ __device__ __forceinline__ size_t xblk_off(int row, int col, int ncols) { return ((size_t)(row >> 4) * (ncols >> 5) + (col >> 5)) * 512 + (size_t)((row & 15) * 32 + (col & 31)); }
struct Unit { int pm, pn; };
struct Gemm { const bf16_t* A; const bf16_t* Bt; int M, N, K; int amask = -1, bmask = -1; };

struct StaticOrder {
    int nM, nN, nwg, G, c, wgm; bool rev = false;
    __host__ __device__ void init(int M, int N, int G_, int c_, int wgm_ = WGM) { nM = M / BM; nN = N / BM; nwg = nM * nN; G = G_; c = c_; wgm = wgm_; }
    __host__ __device__ bool next(int i, Unit& u) const {
        const long L = (long)i * G + c; if (L >= nwg) return false;
        int wgid = (int)L; { const int q = nwg / NXCD, r = nwg % NXCD, xcd = wgid % NXCD, off = wgid / NXCD; wgid = (xcd < r ? xcd * (q + 1) : r * (q + 1) + (xcd - r) * q) + off; }
        const int nig = wgm * nN, gid = wgid / nig, fm = gid * wgm, gsz = (nM - fm) < wgm ? (nM - fm) : wgm;
        u.pm = fm + ((wgid % nig) % gsz); u.pn = (wgid % nig) / gsz; if (rev) u.pm = nM - 1 - u.pm; return true;
    }
    __device__ __forceinline__ void a_ready(const Unit&) const {}
    __device__ __forceinline__ void done(const Unit&) const {}
};

__device__ __forceinline__ unsigned cvt_pk_bf16(float lo, float hi) { unsigned r; asm volatile("v_cvt_pk_bf16_f32 %0, %1, %2" : "=v"(r) : "v"(lo), "v"(hi)); return r; }
typedef float f32x2 __attribute__((ext_vector_type(2)));
__device__ __forceinline__ f32x2 gelu_pk(f32x2 v) {
    const f32x2 av = __builtin_elementwise_abs(v), d = av * 0.2316418882f + 1.0f;
    f32x2 t; t.x = __builtin_amdgcn_rcpf(d.x); t.y = __builtin_amdgcn_rcpf(d.y);
    f32x2 q = t * 0.5307027145f + (-0.7265760135f); q = q * t + 0.7107068705f; q = q * t + (-0.142248368f); q = q * t + 0.127414796f; q = q * t;
    const f32x2 s = (v * v) * (-0.72134752044f);
    f32x2 e; e.x = __builtin_amdgcn_exp2f(s.x); e.y = __builtin_amdgcn_exp2f(s.y);
    const f32x2 m = v * (q * e), r = v - m;
    f32x2 o; o.x = v.x < 0.f ? m.x : r.x; o.y = v.y < 0.f ? m.y : r.y; return o;
}

template <int ACT  > struct EpiBf16 {
    static constexpr bool PERM = true, AFTER_DRAIN = false; static_assert(ACT == 0 || ACT == 1, "EpiBf16: ACT is 0 (none) or 1 (gelu_pk)");
    bf16_t* O; int ldc; const float* bias; int split_cols; size_t split_stride; float scale0;
    __device__ __forceinline__ void operator()(const f32x4 (&acc)[2][2][4][2], const Unit& u, int wr, int wc, int fr, int fq) const {
        const int row0 = u.pm * BM + wr * 64 + fr; int colt = u.pn * BM; bf16_t* base = O;
        float sc = 1.f; if (split_cols) { const int t = colt / split_cols; base += (size_t)t * split_stride; colt -= t * split_cols; if (t == 0) sc = scale0; }
        const int col0 = colt + wc * 32 + 8 * fq, bcol0 = u.pn * BM + wc * 32 + 8 * fq;
        f32x4 bv[2][2];
#pragma unroll
        for (int bj = 0; bj < 2; ++bj)
#pragma unroll
            for (int n = 0; n < 2; ++n) bv[bj][n] = bias ? *(const f32x4*)(bias + bcol0 + bj * HALF + 4 * n) : (f32x4){0.f, 0.f, 0.f, 0.f};
#pragma unroll
        for (int ai = 0; ai < 2; ++ai)
#pragma unroll
            for (int m = 0; m < 4; ++m) { bf16_t* rowp = base + (size_t)(row0 + ai * HALF + m * 16) * ldc + col0;
#pragma unroll
                for (int bj = 0; bj < 2; ++bj) { f32x4 v0 = acc[ai][bj][m][0] + bv[bj][0], v1 = acc[ai][bj][m][1] + bv[bj][1];
                    if (ACT == 1) { f32x2 a = gelu_pk((f32x2){v0[0], v0[1]}), b = gelu_pk((f32x2){v0[2], v0[3]}), c = gelu_pk((f32x2){v1[0], v1[1]}), d = gelu_pk((f32x2){v1[2], v1[3]});
                        v0 = (f32x4){a.x, a.y, b.x, b.y}; v1 = (f32x4){c.x, c.y, d.x, d.y}; }
                    v0 = v0 * sc; v1 = v1 * sc; u32x4 w; w.x = cvt_pk_bf16(v0[0], v0[1]); w.y = cvt_pk_bf16(v0[2], v0[3]); w.z = cvt_pk_bf16(v1[0], v1[1]); w.w = cvt_pk_bf16(v1[2], v1[3]);
                    *(u32x4*)(rowp + bj * HALF) = w; } }
    }
};

struct EpiRelu2 {
    static constexpr bool PERM = true, AFTER_DRAIN = false;
    bf16_t* O; int ldc;
    __device__ __forceinline__ void operator()(const f32x4 (&acc)[2][2][4][2], const Unit& u, int wr, int wc, int fr, int fq) const {
        const int row0 = u.pm * BM + wr * 64 + fr; const int col0 = u.pn * BM + wc * 32 + 8 * fq;
#pragma unroll
        for (int ai = 0; ai < 2; ++ai)
#pragma unroll
            for (int m = 0; m < 4; ++m) { const int row = row0 + ai * HALF + m * 16;
#pragma unroll
                for (int bj = 0; bj < 2; ++bj) { f32x4 v0 = acc[ai][bj][m][0], v1 = acc[ai][bj][m][1];
                    v0 = __builtin_elementwise_max(v0, (f32x4){0.f, 0.f, 0.f, 0.f}); v1 = __builtin_elementwise_max(v1, (f32x4){0.f, 0.f, 0.f, 0.f});
                    v0 = v0 * v0; v1 = v1 * v1;
                    u32x4 w; w.x = cvt_pk_bf16(v0[0], v0[1]); w.y = cvt_pk_bf16(v0[2], v0[3]); w.z = cvt_pk_bf16(v1[0], v1[1]); w.w = cvt_pk_bf16(v1[2], v1[3]);
                    *(u32x4*)(O + subtiled_off(row, col0 + bj * HALF, ldc)) = w; } }
    }
};
typedef _Float16 h16x2 __attribute__((ext_vector_type(2)));
__device__ __forceinline__ unsigned res_pk(float lo, float hi) { const h16x2 h = {(_Float16)lo, (_Float16)hi}; return __builtin_bit_cast(unsigned, h); }
__device__ __forceinline__ float res_lo(unsigned w) { return (float)__builtin_bit_cast(h16x2, w).x; }
__device__ __forceinline__ float res_hi(unsigned w) { return (float)__builtin_bit_cast(h16x2, w).y; }
struct EpiGateRes {
    static constexpr bool PERM = true, AFTER_DRAIN = false;
    const bf16_t* base; bf16_t* out; int ldc; const float* gate; int gate_stride; int panels_per_batch;
    __device__ __forceinline__ void operator()(const f32x4 (&acc)[2][2][4][2], const Unit& u, int wr, int wc, int fr, int fq) const {
        const int row0 = u.pm * BM + wr * 64 + fr; const int col0 = u.pn * BM + wc * 32 + 8 * fq;
        const float* gp = gate + (size_t)(u.pm / panels_per_batch) * gate_stride + col0;
        f32x4 gv[2][2];
#pragma unroll
        for (int bj = 0; bj < 2; ++bj)
#pragma unroll
            for (int n = 0; n < 2; ++n) gv[bj][n] = *(const f32x4*)(gp + bj * HALF + 4 * n);
#pragma unroll
        for (int ai = 0; ai < 2; ++ai) {
            u32x4 bsv[4][2];
#pragma unroll
            for (int m = 0; m < 4; ++m)
#pragma unroll
                for (int bj = 0; bj < 2; ++bj) bsv[m][bj] = *(const u32x4*)(base + xblk_off(row0 + ai * HALF + m * 16, col0 + bj * HALF, ldc));
#pragma unroll
            for (int m = 0; m < 4; ++m) {
#pragma unroll
                for (int bj = 0; bj < 2; ++bj) { const u32x4 bs = bsv[m][bj];
                    const f32x4 v0 = gv[bj][0] * acc[ai][bj][m][0], v1 = gv[bj][1] * acc[ai][bj][m][1];
                    u32x4 w;
                    w.x = res_pk(res_lo(bs.x) + v0[0], res_hi(bs.x) + v0[1]);
                    w.y = res_pk(res_lo(bs.y) + v0[2], res_hi(bs.y) + v0[3]);
                    w.z = res_pk(res_lo(bs.z) + v1[0], res_hi(bs.z) + v1[1]);
                    w.w = res_pk(res_lo(bs.w) + v1[2], res_hi(bs.w) + v1[3]);
                    *(u32x4*)(out + xblk_off(row0 + ai * HALF + m * 16, col0 + bj * HALF, ldc)) = w; } }
            asm volatile("" ::: "memory");
        }
    }
};

constexpr int ZSEQ = 4096;
constexpr int ZO_Q = 0, ZO_K = 12582912, ZO_V = 25165824, ZO_G = 37748736, ZO_P = 50331648, ZO_GQ = 58720256, ZO_GK = 65011712, ZO_GV = 71303168, ZO_GR = 83886080, ZO_GZ = 96468992;
__device__ __forceinline__ int zmap(int cg, int bq, int& grp, int& rs) {
    const bool r1 = cg < 3072, r2 = cg < 3584, r3 = cg < 4352, r4 = cg < 5888, r5 = cg < 5904;
    const int csA = r1 ? cg : cg - 3072;
    const int secA = r1 ? cg / 768 : 0, inA = r1 ? cg % 768 : csA, cA = inA & 127;
    const int offA = (r1 ? secA * ZO_K : ZO_P) + ((bq * (r1 ? 6 : 4) + (inA >> 7)) * ZSEQ) * 128 + (cA >> 5) * 512 + (cA & 31);
    const int csB = cg - 3584, s2B = csB / 384, rB = csB % 384, cB = rB % 96;
    const int offB = ZO_GQ + s2B * (ZO_GK - ZO_GQ) + ((bq * 4 + rB / 96) * ZSEQ) * 96 + (cB >> 5) * 512 + (cB & 31);
    const int csC = cg - 4352, s2C = csC / 768, rC = csC % 768, cC = rC % 192;
    const int offC = ZO_GV + s2C * (ZO_GR - ZO_GV) + ((bq * 4 + rC / 192) * ZSEQ) * 192 + (cC >> 5) * 512 + (cC & 31);
    const int offD = ZO_GZ + bq * ZSEQ * 16 + (cg - 5888);
    grp = r2 ? 16 * 128 : (r3 ? 16 * 96 : (r4 ? 16 * 192 : (r5 ? 256 : 0)));
    rs = r4 ? 32 : 16;
    return r2 ? offA : (r3 ? offB : (r4 ? offC : offD));
}
struct EpiZ {
    static constexpr bool PERM = true, AFTER_DRAIN = false;
    bf16_t* O; const unsigned* rot;
#if defined(PROBE_AMASK)
    size_t omask = ~(size_t)0;
#endif
    __device__ __forceinline__ void operator()(const f32x4 (&acc)[2][2][4][2], const Unit& u, int wr, int wc, int fr, int fq) const {
#if defined(PROBE_AMASK)
        if (!O) return;
#endif
        const int row0 = u.pm * BM + wr * 64 + fr; const int col0 = u.pn * BM + wc * 32 + 8 * fq;
        const int mode = (u.pn < 6) ? 1 : (((u.pn >= 9 && u.pn < 12) || (u.pn >= 20 && u.pn < 23)) ? 2 : 0);
        const int i0 = wc * 16 + 4 * fq;
        const int bq = (u.pm * BM) / ZSEQ;
        int off[2], grp[2], rs[2];
#pragma unroll
        for (int bj = 0; bj < 2; ++bj) off[bj] = zmap(col0 + bj * HALF, bq, grp[bj], rs[bj]);
        u32x4 rotv[2][4];
        if (mode == 1) {
#pragma unroll
            for (int ai = 0; ai < 2; ++ai)
#pragma unroll
                for (int m = 0; m < 4; ++m) rotv[ai][m] = *(const u32x4*)(rot + (size_t)((row0 + ai * HALF + m * 16) & (ZSEQ - 1)) * 64 + i0);
        }
#pragma unroll
        for (int ai = 0; ai < 2; ++ai) {
#pragma unroll
            for (int m = 0; m < 4; ++m) { const int row = row0 + ai * HALF + m * 16; const int t = row & (ZSEQ - 1);
                f32x4 cs = {1.f, 1.f, 1.f, 1.f}, sn = {0.f, 0.f, 0.f, 0.f};
                if (mode == 1) { const u32x4 q = rotv[ai][m]; cs = (f32x4){res_lo(q.x), res_lo(q.y), res_lo(q.z), res_lo(q.w)}; sn = (f32x4){res_hi(q.x), res_hi(q.y), res_hi(q.z), res_hi(q.w)}; }
#pragma unroll
                for (int bj = 0; bj < 2; ++bj) { f32x4 v0 = acc[ai][bj][m][0], v1 = acc[ai][bj][m][1];
                    if (mode == 1) {
                        const f32x4 a0 = v0, a1 = v1;
                        v0[0] = a0[0] * cs[0] - a0[1] * sn[0]; v0[1] = a0[0] * sn[0] + a0[1] * cs[0];
                        v0[2] = a0[2] * cs[1] - a0[3] * sn[1]; v0[3] = a0[2] * sn[1] + a0[3] * cs[1];
                        v1[0] = a1[0] * cs[2] - a1[1] * sn[2]; v1[1] = a1[0] * sn[2] + a1[1] * cs[2];
                        v1[2] = a1[2] * cs[3] - a1[3] * sn[3]; v1[3] = a1[2] * sn[3] + a1[3] * cs[3];
                    } else if (mode == 2) {
#pragma unroll
                        for (int e = 0; e < 4; ++e) { v0[e] = v0[e] * __builtin_amdgcn_rcpf(1.f + __expf(-v0[e])); v1[e] = v1[e] * __builtin_amdgcn_rcpf(1.f + __expf(-v1[e])); }
                    }
                    u32x4 wv; wv.x = cvt_pk_bf16(v0[0], v0[1]); wv.y = cvt_pk_bf16(v0[2], v0[3]); wv.z = cvt_pk_bf16(v1[0], v1[1]); wv.w = cvt_pk_bf16(v1[2], v1[3]);
#if defined(PROBE_AMASK)
                    if (grp[bj] != 0 && (omask != 0 || wv.x == 0x12345678u)) *(u32x4*)(O + ((size_t)(unsigned)(off[bj] + (t >> 4) * grp[bj] + (t & 15) * rs[bj]) & omask)) = wv; } }
#else
                    if (grp[bj] != 0) *(u32x4*)(O + (size_t)(unsigned)(off[bj] + (t >> 4) * grp[bj] + (t & 15) * rs[bj])) = wv; } }
#endif
        }
    }
};

template <class Epi, class Sched, bool ALIGN_EPI = false, bool SP2 = false, bool TILED = true, bool ASUB = false, bool AROWMAJOR = false>
__device__ __forceinline__ void gemm_phase(PG8_LAS unsigned char* lds, const Gemm g, const Sched& S, const Epi& E) {
    int tid_ = threadIdx.x; asm volatile("" : "+v"(tid_));
    const int tid = tid_, wid = __builtin_amdgcn_readfirstlane(tid >> 6), lane = tid & 63, wr = wid >> 2, wc = wid & 3, fr = lane & 15, fq = lane >> 4;
    const int K = g.K, nt = K / BK;
    unsigned voffA[2], voffB[2];
#pragma unroll
    for (int i = 0; i < 2; ++i) { int R, C; stage_rc(tid * 16 + i * 8192, R, C); const int Rb = Epi::PERM ? ((R & ~31) + perm32(R & 31)) : R;
        voffA[i] = ASUB ? (unsigned)((((R >> 4) * 2 + (C >> 5)) << 9) + (R & 15) * 32 + (C & 31)) * 2u : (unsigned)(R * ((TILED && !AROWMAJOR) ? BK : K) + C) * 2u; voffB[i] = (unsigned)(Rb * (TILED ? BK : K) + C) * 2u; }
    const size_t kstep = TILED ? (size_t)(BM * BK * 2) : (size_t)(BK * 2);
    const size_t hstep = TILED ? (size_t)(HALF * BK * 2) : (size_t)HALF * K * 2;
    const size_t tstep = TILED ? (size_t)nt * (BM * BK * 2) : 2 * (size_t)HALF * K * 2;
    const size_t kstepA = (TILED && !AROWMAJOR) ? kstep : (size_t)(BK * 2), hstepA = (TILED && !AROWMAJOR) ? hstep : (size_t)HALF * K * 2, tstepA = (TILED && !AROWMAJOR) ? tstep : 2 * (size_t)HALF * K * 2;
    const unsigned ldsw = (unsigned)wid * 1024u;
    const int aoff = lds_byte(wr * 64 + fr, fq * 8), boff = lds_byte(wc * 32 + fr, fq * 8);
#define PG8_SA(b, h) (((b) * 2 + (h)) * HTB)
#define PG8_SB(b, h) ((4 + (b) * 2 + (h)) * HTB)
#define PG8_STAGE(bufoff, gbase, voff) do { _Pragma("unroll") for (int _i = 0; _i < 2; ++_i) \
        __builtin_amdgcn_global_load_lds((const unsigned*)((const char*)(gbase) + (voff)[_i]), (PG8_LAS unsigned*)(lds + (bufoff) + ldsw + _i * 8192), 16, 0, 0); } while (0)
#define PG8_LDA(dst, b, h) do { _Pragma("unroll") for (int m = 0; m < 4; ++m) _Pragma("unroll") for (int k = 0; k < 2; ++k) dst[m][k] = *(const PG8_LAS bf16x8*)(lds + PG8_SA(b, h) + aoff + m * 2048 + k * 1024); } while (0)
#define PG8_LDB(dst, b, h) do { _Pragma("unroll") for (int n = 0; n < 2; ++n) _Pragma("unroll") for (int k = 0; k < 2; ++k) dst[n][k] = *(const PG8_LAS bf16x8*)(lds + PG8_SB(b, h) + boff + n * 2048 + k * 1024); } while (0)
#define PG8_MMA(ai, bj, At, Bt) do { __builtin_amdgcn_s_setprio(1); _Pragma("unroll") for (int m = 0; m < 4; ++m) _Pragma("unroll") for (int n = 0; n < 2; ++n) _Pragma("unroll") for (int k = 0; k < 2; ++k) \
        acc[ai][bj][m][n] = __builtin_amdgcn_mfma_f32_16x16x32_bf16(Bt[n][k], At[m][k], acc[ai][bj][m][n], 0, 0, 0); __builtin_amdgcn_s_setprio(0); } while (0)
#define PG8_WAIT_V(n) asm volatile("s_waitcnt vmcnt(" #n ")" ::: "memory")
#define PG8_WAIT_L(n) asm volatile("s_waitcnt lgkmcnt(" #n ")" ::: "memory")
#define PG8_BAR __builtin_amdgcn_s_barrier()
#define PG8_SCHED __builtin_amdgcn_sched_barrier(0)
    Unit cur, nxt; int ui = 0;
    if (!S.next(0, cur)) return;
    f32x4 acc[2][2][4][2];
#pragma unroll
    for (int a = 0; a < 2; ++a)
#pragma unroll
        for (int b = 0; b < 2; ++b)
#pragma unroll
            for (int m = 0; m < 4; ++m)
#pragma unroll
                for (int n = 0; n < 2; ++n) acc[a][b][m][n] = (f32x4){0.f, 0.f, 0.f, 0.f};
    bf16x8 At[4][2], B0[2][2], B1[2][2];
    const char* cA = (const char*)g.A + (size_t)(cur.pm & g.amask) * tstepA; const char* cB = (const char*)g.Bt + (size_t)(cur.pn & g.bmask) * tstep;
    S.a_ready(cur);
    if constexpr (SP2) {
        PG8_STAGE(PG8_SB(0, 0), cB, voffB); PG8_STAGE(PG8_SB(0, 1), cB + hstep, voffB); PG8_STAGE(PG8_SA(0, 0), cA, voffA); PG8_STAGE(PG8_SA(0, 1), cA + hstepA, voffA);
        if (wr == 1) PG8_BAR;
        PG8_WAIT_V(2); PG8_BAR;
        PG8_STAGE(PG8_SB(1, 0), cB + kstep, voffB); PG8_STAGE(PG8_SA(1, 0), cA + kstepA, voffA); PG8_STAGE(PG8_SB(1, 1), cB + hstep + kstep, voffB);
        PG8_WAIT_V(6); PG8_BAR;
    } else {
        PG8_STAGE(PG8_SB(0, 0), cB, voffB); PG8_STAGE(PG8_SA(0, 0), cA, voffA); PG8_STAGE(PG8_SB(0, 1), cB + hstep, voffB); PG8_STAGE(PG8_SA(0, 1), cA + hstepA, voffA);
        if (wr == 1) PG8_BAR;
        PG8_WAIT_V(4); PG8_BAR;
        PG8_STAGE(PG8_SB(1, 0), cB + kstep, voffB); PG8_STAGE(PG8_SA(1, 0), cA + kstepA, voffA); PG8_STAGE(PG8_SB(1, 1), cB + hstep + kstep, voffB);
        PG8_WAIT_V(6); PG8_BAR;
    }
    for (;;) {
        const bool has_next = S.next(ui + 1, nxt);
        const char* nA = has_next ? (const char*)g.A + (size_t)(nxt.pm & g.amask) * tstepA : cA; const char* nB = has_next ? (const char*)g.Bt + (size_t)(nxt.pn & g.bmask) * tstep : cB;
        for (int t = 0; t < nt; t += 2) {
            const bool last = (t == nt - 2);
            const char* a1 = cA + (size_t)(t + 1) * kstepA;
            const char* a2 = last ? nA : cA + (size_t)(t + 2) * kstepA; const char* b2 = last ? nB : cB + (size_t)(t + 2) * kstep;
            const char* a3 = a2 + kstepA; const char* b3 = b2 + kstep;
            if (last && has_next) S.a_ready(nxt);
            if constexpr (SP2) {
            PG8_LDB(B0, 0, 0); PG8_LDB(B1, 0, 1); PG8_SCHED; PG8_LDA(At, 0, 0); PG8_STAGE(PG8_SA(1, 1), a1 + hstepA, voffA);
            PG8_WAIT_V(8); PG8_WAIT_L(0); PG8_BAR; PG8_MMA(0, 0, At, B0); PG8_MMA(0, 1, At, B1); PG8_BAR; PG8_SCHED;
            PG8_LDA(At, 0, 1); PG8_STAGE(PG8_SB(0, 0), b2, voffB); PG8_STAGE(PG8_SB(0, 1), b2 + hstep, voffB); PG8_STAGE(PG8_SA(0, 0), a2, voffA);
            PG8_WAIT_V(8); PG8_WAIT_L(0); PG8_BAR; PG8_MMA(1, 0, At, B0); PG8_MMA(1, 1, At, B1); PG8_BAR; PG8_SCHED;
            PG8_LDB(B0, 1, 0); PG8_LDB(B1, 1, 1); PG8_SCHED; PG8_LDA(At, 1, 0); PG8_STAGE(PG8_SA(0, 1), a2 + hstepA, voffA);
            PG8_WAIT_V(8); PG8_WAIT_L(0); PG8_BAR; PG8_MMA(0, 0, At, B0); PG8_MMA(0, 1, At, B1); PG8_BAR; PG8_SCHED;
            PG8_LDA(At, 1, 1); PG8_STAGE(PG8_SB(1, 0), b3, voffB); PG8_STAGE(PG8_SB(1, 1), b3 + hstep, voffB); PG8_STAGE(PG8_SA(1, 0), a3, voffA);
            PG8_WAIT_V(8); PG8_WAIT_L(0); PG8_BAR; PG8_MMA(1, 0, At, B0); PG8_MMA(1, 1, At, B1); PG8_BAR; PG8_SCHED;
            } else {
            PG8_LDB(B0, 0, 0); PG8_SCHED; PG8_LDA(At, 0, 0); PG8_STAGE(PG8_SA(1, 1), a1 + hstepA, voffA);
            PG8_WAIT_L(8); PG8_BAR; PG8_WAIT_L(0); PG8_MMA(0, 0, At, B0); PG8_BAR; PG8_SCHED;
            PG8_LDB(B1, 0, 1); PG8_STAGE(PG8_SB(0, 0), b2, voffB);
            PG8_BAR; PG8_WAIT_L(0); PG8_MMA(0, 1, At, B1); PG8_BAR;
            PG8_LDA(At, 0, 1); PG8_STAGE(PG8_SA(0, 0), a2, voffA);
            PG8_BAR; PG8_WAIT_L(0); PG8_MMA(1, 0, At, B0); PG8_BAR; PG8_SCHED;
            PG8_STAGE(PG8_SB(0, 1), b2 + hstep, voffB);
            PG8_WAIT_V(6); PG8_BAR; PG8_MMA(1, 1, At, B1); PG8_BAR;
            PG8_LDB(B0, 1, 0); PG8_SCHED; PG8_LDA(At, 1, 0); PG8_STAGE(PG8_SA(0, 1), a2 + hstepA, voffA);
            PG8_WAIT_L(8); PG8_BAR; PG8_WAIT_L(0); PG8_MMA(0, 0, At, B0); PG8_BAR; PG8_SCHED;
            PG8_LDB(B1, 1, 1); PG8_STAGE(PG8_SB(1, 0), b3, voffB);
            PG8_BAR; PG8_WAIT_L(0); PG8_MMA(0, 1, At, B1); PG8_BAR;
            PG8_LDA(At, 1, 1); PG8_STAGE(PG8_SA(1, 0), a3, voffA);
            PG8_BAR; PG8_WAIT_L(0); PG8_MMA(1, 0, At, B0); PG8_BAR; PG8_SCHED;
            PG8_STAGE(PG8_SB(1, 1), b3 + hstep, voffB);
            PG8_WAIT_V(6); PG8_BAR; PG8_MMA(1, 1, At, B1); PG8_BAR;
            }
        }
        if constexpr (ALIGN_EPI) { if (wr == 0) PG8_BAR; }
        if constexpr (!Epi::AFTER_DRAIN) { E(acc, cur, wr, wc, fr, fq); S.done(cur); }
        if (!has_next) break;
#pragma unroll
        for (int a = 0; a < 2; ++a)
#pragma unroll
            for (int b = 0; b < 2; ++b)
#pragma unroll
                for (int m = 0; m < 4; ++m)
#pragma unroll
                    for (int n = 0; n < 2; ++n) acc[a][b][m][n] = (f32x4){0.f, 0.f, 0.f, 0.f};
        cur = nxt; cA = nA; cB = nB; ++ui;
        if constexpr (ALIGN_EPI) { if (wr == 1) PG8_BAR; }
    }
    PG8_WAIT_V(0);
    if constexpr (!ALIGN_EPI) { if (wr == 0) PG8_BAR; }
    PG8_BAR;
    if constexpr (Epi::AFTER_DRAIN) { E.fused(acc, cur, wr, wc, fr, fq, lds, wid, lane); S.done(cur); }
#undef PG8_SA
#undef PG8_SB
#undef PG8_STAGE
#undef PG8_LDA
#undef PG8_LDB
#undef PG8_MMA
#undef PG8_WAIT_V
#undef PG8_WAIT_L
#undef PG8_BAR
#undef PG8_SCHED
}
}

constexpr int NWAVES = 8, NTHR = NWAVES * 64;
constexpr int BATCH = 4, SEQ = 4096, DM = 2048, DEPTH = 4, DFF = 8192;
constexpr int M = BATCH * SEQ;
constexpr int NIN = 5904, NZ = 6144;
using pg8::ZO_Q; using pg8::ZO_K; using pg8::ZO_V; using pg8::ZO_G; using pg8::ZO_P; using pg8::ZO_GQ; using pg8::ZO_GK; using pg8::ZO_GV; using pg8::ZO_GR; using pg8::ZO_GZ;
constexpr int MIX_RET = 0, MIX_POOL = 768, MIX_GLA = 1280;
constexpr int RH = 6, RD = 128, RC = 128, RNC = SEQ / RC;
constexpr int GH = 4, GDK = 96, GDV = 192, GC = 64, GNC = SEQ / GC;
constexpr int NMOD = 6 * DM;
constexpr float EPS = 1e-6f;
constexpr int KS_ADA = 32;

constexpr size_t MiB = 1u << 20;
constexpr size_t WS_CTL = 0, CTL_ZERO_BYTES = 32768;
constexpr size_t WS_MOD = 1 * MiB;
constexpr size_t WS_MODP = 848 * MiB;
constexpr size_t WS_COS = 10 * MiB;
constexpr size_t WS_GCH = 12 * MiB;
constexpr size_t WS_WIN = 16 * MiB;
constexpr size_t WS_WOUT = 112 * MiB;
constexpr size_t WS_WUP = 144 * MiB;
constexpr size_t WS_WDN = 272 * MiB;
constexpr size_t WS_X = 400 * MiB;
constexpr size_t WS_XN = 528 * MiB;
constexpr size_t WS_Z = 592 * MiB;
constexpr size_t WS_MIX = 784 * MiB;
constexpr size_t WS_H = 848 * MiB;
constexpr size_t WS_URET = 1104 * MiB;
constexpr size_t WS_RPREV = 1152 * MiB;
constexpr size_t WS_UGLA = 1176 * MiB;
constexpr size_t WS_SPREV = 1248 * MiB;
constexpr size_t WS_GB = 1284 * MiB;
constexpr size_t WS_END = 1308 * MiB;
constexpr int CW_BAR = 4096;

constexpr int RING_BYTES = 143360;
constexpr int LDSCTL_OFF = RING_BYTES, MISC_OFF = LDSCTL_OFF + 320;
constexpr int LDS_BYTES = 147456;

#define GAS __attribute__((address_space(1)))
#define LAS __attribute__((address_space(3)))
typedef unsigned short bf16;
typedef unsigned v4u __attribute__((ext_vector_type(4)));
typedef unsigned v2u __attribute__((ext_vector_type(2)));
typedef float f32x4 __attribute__((ext_vector_type(4)));
typedef short bf16x8 __attribute__((ext_vector_type(8)));
typedef short s16x4 __attribute__((ext_vector_type(4)));
typedef GAS unsigned gu32;
#define RLX_AGENT __ATOMIC_RELAXED, __HIP_MEMORY_SCOPE_AGENT

__device__ __forceinline__ unsigned f2bf(float f) { unsigned u = __builtin_bit_cast(unsigned, f); return (u + 0x7fffu + ((u >> 16) & 1u)) >> 16; }
typedef float f32x2_t __attribute__((ext_vector_type(2)));
typedef __bf16 bf16x2_t __attribute__((ext_vector_type(2)));
__device__ __forceinline__ unsigned pk2(float lo, float hi) { const f32x2_t v = {lo, hi}; return __builtin_bit_cast(unsigned, __builtin_convertvector(v, bf16x2_t)); }
__device__ __forceinline__ float bf2f(unsigned h) { return __builtin_bit_cast(float, h << 16); }
__device__ __forceinline__ float bflo(unsigned w) { return __builtin_bit_cast(float, w << 16); }
__device__ __forceinline__ float bfhi(unsigned w) { return __builtin_bit_cast(float, w & 0xffff0000u); }

#define XB_TMO      128
#define XB_XCNT(j)  (256  + 64 * (j))
#define XB_XSUB(j)  (1280 + 64 * (j))
#define XB_XGEN(j)  (2304 + 64 * (j))
#define XB_TOP      3328
#define XB_TOPGEN   3392
#define XCD_BAR_WORDS 3456
#define XB_SPIN_CAP (1u << 18)

__device__ __forceinline__ unsigned xb_ld(unsigned* p)              { return __hip_atomic_load(p, __ATOMIC_RELAXED, __HIP_MEMORY_SCOPE_AGENT); }
__device__ __forceinline__ unsigned xb_add(unsigned* p, unsigned v) { return __hip_atomic_fetch_add(p, v, __ATOMIC_RELAXED, __HIP_MEMORY_SCOPE_AGENT); }
__device__ __forceinline__ unsigned xb_xcc_id() { return (unsigned)__builtin_amdgcn_s_getreg((3 << 11) | 20) & 0xFu; }
#define XB_SPIN(cond, bar) do { unsigned _sp = 0; while (cond) { __builtin_amdgcn_s_sleep(1); \
    if ((++_sp & 255u) == 0u) { if (xb_ld(&(bar)[XB_TMO])) break; if (_sp > XB_SPIN_CAP) { atomicAdd(&(bar)[XB_TMO], 1u); break; } } } } while (0)

struct XcdBarrier {
    unsigned* bar; unsigned x;
    volatile LAS unsigned* st;
};

__device__ __forceinline__ XcdBarrier xcd_barrier_post(unsigned* bar, volatile LAS unsigned* st) {
    XcdBarrier b; b.bar = bar; b.x = xb_xcc_id(); b.st = st;
    if (threadIdx.x == 0) (void)xb_add(&bar[XB_XCNT(b.x)], 1u);
    return b;
}
__device__ __forceinline__ void xcd_barrier_complete(unsigned* bar, unsigned x, unsigned& nloc, unsigned& nx) {
    const unsigned G = gridDim.x * gridDim.y * gridDim.z;
    unsigned sum, cnt, mine, sp = 0u;
    for (;;) {
        sum = 0u; cnt = 0u; mine = 0u;
#pragma unroll
        for (unsigned j = 0; j < 16; ++j) { const unsigned c = xb_ld(&bar[XB_XCNT(j)]); sum += c; cnt += (c > 0u) ? 1u : 0u; mine = (j == x) ? c : mine; }
        if (sum == G) break;
        __builtin_amdgcn_s_sleep(1);
        if ((++sp & 255u) == 0u) { if (xb_ld(&bar[XB_TMO])) break; if (sp > XB_SPIN_CAP) { atomicAdd(&bar[XB_TMO], 1u); break; } }
    }
    nloc = mine > 0u ? mine : 1u; nx = cnt > 0u ? cnt : 1u;
}

__device__ __forceinline__ void xcd_barrier(const XcdBarrier& b) {
    asm volatile("s_waitcnt vmcnt(0)" ::: "memory");
    __syncthreads();
    if (threadIdx.x == 0) {
        unsigned* bar = b.bar;
        __builtin_amdgcn_s_waitcnt(0);
        unsigned nloc = b.st[0], nx = b.st[1];
        if (nloc == 0u) { xcd_barrier_complete(bar, b.x, nloc, nx); b.st[0] = nloc; b.st[1] = nx; }
        const unsigned old = xb_add(&bar[XB_XSUB(b.x)], 1u);
        const unsigned gen = old / nloc;
        if (old + 1u == (gen + 1u) * nloc) {
            __builtin_amdgcn_fence(__ATOMIC_RELEASE, "agent");
            asm volatile("s_waitcnt vmcnt(0)" ::: "memory");
            const unsigned og = xb_add(&bar[XB_TOP], 1u);
            const unsigned tg = og / nx;
            if (og + 1u == (tg + 1u) * nx) xb_add(&bar[XB_TOPGEN], 1u);
            else XB_SPIN(xb_ld(&bar[XB_TOPGEN]) == tg, bar);
            __builtin_amdgcn_fence(__ATOMIC_ACQUIRE, "agent");
            xb_add(&bar[XB_XGEN(b.x)], 1u);
            asm volatile("s_waitcnt vmcnt(0)" ::: "memory");
        } else {
            XB_SPIN(xb_ld(&bar[XB_XGEN(b.x)]) == gen, bar);
            __builtin_amdgcn_fence(__ATOMIC_ACQUIRE, "agent");
            asm volatile("s_waitcnt vmcnt(0)" ::: "memory");
        }
    }
    __syncthreads();
}


struct Ctx { LAS unsigned char* lds; int tid, lane, wave, bid, G; };

__device__ __forceinline__ float wave_sum(float v) {
#pragma unroll
    for (int o = 1; o < 64; o <<= 1) v += __shfl_xor(v, o);
    return v;
}
__device__ __forceinline__ float sum16(float v) {
#define SUM16_ROR(n) v += __builtin_bit_cast(float, __builtin_amdgcn_update_dpp(0, __builtin_bit_cast(int, v), 0x120 + (n), 0xf, 0xf, false))
    SUM16_ROR(8); SUM16_ROR(4); SUM16_ROR(2); SUM16_ROR(1); return v;
#undef SUM16_ROR
}
__device__ __forceinline__ float siluf(float x) { return x * __builtin_amdgcn_rcpf(1.f + __expf(-x)); }

#ifndef MIX_MFMA
#define MIX_MFMA 1
#endif
#if MIX_MFMA
typedef short v4i16_t __attribute__((ext_vector_type(4)));
template <bool TR> __device__ __forceinline__ bf16x8 ldfrag(const LAS bf16* T, int ld, int x0, int k0, int lane) {
    const int g = lane >> 4, c = lane & 15;
    if constexpr (!TR) { return *(const LAS bf16x8*)(T + (x0 + c) * ld + k0 + 8 * g); }
    else {
        const int q = c >> 2, p = c & 3;
        const LAS bf16* p0 = T + (k0 + 8 * g + q) * ld + x0 + 4 * p;
        const s16x4 lo = __builtin_bit_cast(s16x4, __builtin_amdgcn_ds_read_tr16_b64_v4i16((LAS v4i16_t*)p0));
        const s16x4 hi = __builtin_bit_cast(s16x4, __builtin_amdgcn_ds_read_tr16_b64_v4i16((LAS v4i16_t*)(p0 + 4 * ld)));
        bf16x8 r; r[0] = lo[0]; r[1] = lo[1]; r[2] = lo[2]; r[3] = lo[3]; r[4] = hi[0]; r[5] = hi[1]; r[6] = hi[2]; r[7] = hi[3]; return r;
    }
}
#endif
template <int K, bool TA, bool TB>
__device__ __forceinline__ void mm16(f32x4& acc, const LAS bf16* A, int lda, int m0, const LAS bf16* B, int ldb, int n0, int lane) {
#if MIX_MFMA
#pragma unroll
    for (int k0 = 0; k0 < K; k0 += 32) {
        const bf16x8 a = ldfrag<TA>(A, lda, m0, k0, lane), b = ldfrag<!TB>(B, ldb, n0, k0, lane);
        acc = __builtin_amdgcn_mfma_f32_16x16x32_bf16(a, b, acc, 0, 0, 0);
    }
#else
    const int g = lane >> 4, c = lane & 15;
#pragma unroll 4
    for (int k = 0; k < K; ++k) {
        const float bv = bf2f(TB ? B[(n0 + c) * ldb + k] : B[k * ldb + n0 + c]);
#pragma unroll
        for (int r = 0; r < 4; ++r) { const float av = bf2f(TA ? A[k * lda + m0 + 4 * g + r] : A[(m0 + 4 * g + r) * lda + k]); acc[r] += av * bv; }
    }
#endif
}

struct TrItem { const float* W; bf16* WT; int K, N, kb, nb; bool perm; };
__device__ __forceinline__ void tr_issue(f32x4 (&v)[16], const TrItem& t, int lane) {
    const int r4 = lane >> 4, c4 = (lane & 15) * 4;
    const bool ok = 64 * t.nb + c4 < t.N;
    const float* src = t.W + (size_t)(64 * t.kb + r4) * t.N + 64 * t.nb + c4;
#pragma unroll
    for (int i = 0; i < 16; ++i) v[i] = ok ? *(const f32x4*)(src + (size_t)(4 * i) * t.N) : (f32x4){0.f, 0.f, 0.f, 0.f};
}
__device__ __forceinline__ void tr_finish(const f32x4 (&v)[16], const TrItem& t, LAS float* scr, int lane) {
    const int k0 = 64 * t.kb, n0 = 64 * t.nb;
    const int r4 = lane >> 4, c4 = (lane & 15) * 4;
#pragma unroll
    for (int i = 0; i < 16; ++i) { LAS float* d = scr + (4 * i + r4) * 65 + c4; d[0] = v[i].x; d[1] = v[i].y; d[2] = v[i].z; d[3] = v[i].w; }
    asm volatile("s_waitcnt lgkmcnt(0)" ::: "memory");
    const int kc = lane & 7;
#pragma unroll
    for (int j = 0; j < 8; ++j) { const int n = (lane >> 3) + 8 * j; const LAS float* s = scr + (8 * kc) * 65 + n;
        int nout = n0 + n;
        if (t.perm && nout < 1536) { const int w = nout & 127; nout = (nout & ~127) + ((w < 64) ? 2 * w : 2 * (w - 64) + 1); }
        v4u o; o.x = pk2(s[0 * 65], s[1 * 65]); o.y = pk2(s[2 * 65], s[3 * 65]); o.z = pk2(s[4 * 65], s[5 * 65]); o.w = pk2(s[6 * 65], s[7 * 65]);
        *(v4u*)(t.WT + pg8::tiled_off(nout, k0 + 8 * kc, t.K)) = o; }
    asm volatile("s_waitcnt lgkmcnt(0)" ::: "memory");
}

struct P {
    const float *x, *c, *w_ada, *b_ada, *g_mix, *g_mlp, *w_in, *w_gate, *b_gate, *w_pool, *s_pool, *w_out, *w_up, *w_down, *g_final;
    float* out;
    float *mod, *modp, *gch, *gb; unsigned* rot;
    bf16 *win, *wout, *wup, *wdn, *XN, *Z, *MIX, *H, *rprev, *sprev, *uret, *ugla, *X;
};

__device__ __forceinline__ void phase_x_to_bf16(const Ctx& C, const float* x, bf16* X);
__device__ __forceinline__ void phase_prologue(const Ctx& C, const P& p) {
    phase_x_to_bf16(C, p.x, p.X);
    {
        const int gt = C.bid * NTHR + C.tid, NT = C.G * NTHR;
        for (int i = gt; i < SEQ * 64; i += NT) {
            const int pos = i >> 6, f = i & 63;
            const double inv = exp2(-(double)f * (13.287712379549449 / 64.0));
            const double ang = (double)pos * inv;
            const double k = rint(ang * 0.15915494309189535);
            const float r = (float)(ang - k * 6.283185307179586);
            p.rot[i] = pg8::res_pk(cosf(r), sinf(r));
        }
    }
    {
        LAS float* scr = (LAS float*)(C.lds + C.wave * 16640);
        const int gw = C.bid * NWAVES + C.wave, NGW = C.G * NWAVES;
        constexpr int I_IN = (DM / 64) * (NZ / 64), I_OUT = (DM / 64) * (DM / 64), I_UP = (DM / 64) * (DFF / 64), I_DN = (DFF / 64) * (DM / 64);
        constexpr int I_L = I_IN + I_OUT + I_UP + I_DN;
#define TR_ITEM(t, it_) do { const int l_ = (it_) / I_L; int r_ = (it_) % I_L; \
            if (r_ < I_IN) { t = TrItem{p.w_in + (size_t)l_ * DM * NIN, p.win + (size_t)l_ * NZ * DM, DM, NIN, r_ / (NZ / 64), r_ % (NZ / 64), true}; } \
            else if ((r_ -= I_IN) < I_OUT) { t = TrItem{p.w_out + (size_t)l_ * DM * DM, p.wout + (size_t)l_ * DM * DM, DM, DM, r_ / (DM / 64), r_ % (DM / 64), false}; } \
            else if ((r_ -= I_OUT) < I_UP) { t = TrItem{p.w_up + (size_t)l_ * DM * DFF, p.wup + (size_t)l_ * DFF * DM, DM, DFF, r_ / (DFF / 64), r_ % (DFF / 64), false}; } \
            else { r_ -= I_UP; t = TrItem{p.w_down + (size_t)l_ * DFF * DM, p.wdn + (size_t)l_ * DM * DFF, DFF, DM, r_ / (DM / 64), r_ % (DM / 64), false}; } } while (0)
        int it = gw;
        if (it < DEPTH * I_L) {
            TrItem cur, nxt; f32x4 v[16], vn[16];
            TR_ITEM(cur, it); tr_issue(v, cur, C.lane);
            for (;;) {
                const int ni = it + NGW; const bool more = ni < DEPTH * I_L;
                if (more) { TR_ITEM(nxt, ni); tr_issue(vn, nxt, C.lane); }
                tr_finish(v, cur, scr, C.lane);
                if (!more) break;
                cur = nxt; it = ni;
#pragma unroll
                for (int i = 0; i < 16; ++i) v[i] = vn[i];
            }
        }
#undef TR_ITEM
    }
    __syncthreads();
    LAS float* sc = (LAS float*)C.lds;
    for (int i = C.tid; i < BATCH * DM; i += NTHR) sc[i] = siluf(p.c[i]);
    __syncthreads();
    {
        const int gw = C.bid * NWAVES + C.wave, NGW = C.G * NWAVES;
        constexpr int NB = NMOD / 256, KC = DM / KS_ADA;
        for (int it = gw; it < DEPTH * NB * KS_ADA; it += NGW) {
            const int ks = it % KS_ADA, nb = (it / KS_ADA) % NB, l = it / (KS_ADA * NB);
            const float* wp = p.w_ada + ((size_t)l * DM + (size_t)ks * KC) * NMOD + nb * 256 + C.lane * 4;
            f32x4 a0 = {0.f, 0.f, 0.f, 0.f}, a1 = a0, a2 = a0, a3 = a0;
#pragma unroll 16
            for (int k = 0; k < KC; ++k) {
                const f32x4 w = *(const f32x4*)(wp + (size_t)k * NMOD);
                const int kk = ks * KC + k;
                a0 += w * sc[0 * DM + kk]; a1 += w * sc[1 * DM + kk]; a2 += w * sc[2 * DM + kk]; a3 += w * sc[3 * DM + kk];
            }
            float* o = p.modp + (((size_t)ks * DEPTH + l) * BATCH) * NMOD + nb * 256 + C.lane * 4;
            *(f32x4*)(o + 0 * NMOD) = a0; *(f32x4*)(o + 1 * NMOD) = a1; *(f32x4*)(o + 2 * NMOD) = a2; *(f32x4*)(o + 3 * NMOD) = a3;
        }
    }
    __syncthreads();
}

__device__ __forceinline__ void phase_modfin(const Ctx& C, const P& p) {
    const int gt = C.bid * NTHR + C.tid, NT = C.G * NTHR;
    for (int i = gt; i < DEPTH * BATCH * NMOD; i += NT) {
        const int n = i % NMOD, l = i / (BATCH * NMOD);
        float s = p.b_ada[l * NMOD + n];
#pragma unroll
        for (int ks = 0; ks < KS_ADA; ++ks) s += p.modp[(size_t)ks * DEPTH * BATCH * NMOD + i];
        p.mod[i] = s;
    }
}

__device__ __forceinline__ void phase_norm_mod(const Ctx& C, const bf16* x, const float* g, const float* sh, const float* scl, bf16* xn) {
    const int gw = C.bid * NWAVES + C.wave, NGW = C.G * NWAVES;
    for (int r0 = gw * 8; r0 < M; r0 += NGW * 8) {
        const int b = r0 / SEQ;
        f32x4 a[8], s[8];
#pragma unroll
        for (int j = 0; j < 4; ++j)
#pragma unroll
            for (int hh = 0; hh < 2; ++hh) { const int col = (C.lane + 64 * j) * 8 + 4 * hh; const f32x4 gv = *(const f32x4*)(g + col), sv = *(const f32x4*)(scl + (size_t)b * NMOD + col);
                a[2 * j + hh] = gv * (sv + 1.0f); s[2 * j + hh] = *(const f32x4*)(sh + (size_t)b * NMOD + col); }
        v4u qn[4];
#pragma unroll
        for (int j = 0; j < 4; ++j) qn[j] = *(const v4u*)(x + pg8::xblk_off(r0, (C.lane + 64 * j) * 8, DM));
#pragma unroll 1
        for (int r = r0; r < r0 + 8; ++r) {
            v4u qc[4];
#pragma unroll
            for (int j = 0; j < 4; ++j) qc[j] = qn[j];
            if (r + 1 < r0 + 8) {
#pragma unroll
                for (int j = 0; j < 4; ++j) qn[j] = *(const v4u*)(x + pg8::xblk_off(r + 1, (C.lane + 64 * j) * 8, DM)); }
            f32x4 v[8]; float ss = 0.f;
#pragma unroll
            for (int j = 0; j < 4; ++j) { const v4u q = qc[j];
                v[2 * j] = (f32x4){pg8::res_lo(q.x), pg8::res_hi(q.x), pg8::res_lo(q.y), pg8::res_hi(q.y)}; v[2 * j + 1] = (f32x4){pg8::res_lo(q.z), pg8::res_hi(q.z), pg8::res_lo(q.w), pg8::res_hi(q.w)}; }
#pragma unroll
            for (int j = 0; j < 8; ++j) ss += (v[j].x * v[j].x + v[j].y * v[j].y) + (v[j].z * v[j].z + v[j].w * v[j].w);
            const float rstd = __builtin_amdgcn_rsqf(wave_sum(ss) * (1.0f / DM) + EPS);
#pragma unroll
            for (int j = 0; j < 4; ++j) { const f32x4 y0 = v[2 * j] * rstd * a[2 * j] + s[2 * j], y1 = v[2 * j + 1] * rstd * a[2 * j + 1] + s[2 * j + 1];
                v4u w; w.x = pk2(y0.x, y0.y); w.y = pk2(y0.z, y0.w); w.z = pk2(y1.x, y1.y); w.w = pk2(y1.z, y1.w);
                *(v4u*)(xn + (size_t)r * DM + (C.lane + 64 * j) * 8) = w; }
        }
    }
}
__device__ __forceinline__ void phase_norm_final(const Ctx& C, const bf16* x, const float* g, float* out) {
    const int gw = C.bid * NWAVES + C.wave, NGW = C.G * NWAVES;
    if (gw >= M) return;
    v4u qn[4];
#pragma unroll
    for (int j = 0; j < 4; ++j) qn[j] = *(const v4u*)(x + pg8::xblk_off(gw, (C.lane + 64 * j) * 8, DM));
#pragma unroll 1
    for (int r = gw; r < M; r += NGW) {
        v4u qc[4];
#pragma unroll
        for (int j = 0; j < 4; ++j) qc[j] = qn[j];
        if (r + NGW < M) {
#pragma unroll
            for (int j = 0; j < 4; ++j) qn[j] = *(const v4u*)(x + pg8::xblk_off(r + NGW, (C.lane + 64 * j) * 8, DM)); }
        f32x4 v[8]; float ss = 0.f;
#pragma unroll
        for (int j = 0; j < 4; ++j) { const v4u q = qc[j];
            v[2 * j] = (f32x4){pg8::res_lo(q.x), pg8::res_hi(q.x), pg8::res_lo(q.y), pg8::res_hi(q.y)}; v[2 * j + 1] = (f32x4){pg8::res_lo(q.z), pg8::res_hi(q.z), pg8::res_lo(q.w), pg8::res_hi(q.w)}; }
#pragma unroll
        for (int j = 0; j < 8; ++j) ss += (v[j].x * v[j].x + v[j].y * v[j].y) + (v[j].z * v[j].z + v[j].w * v[j].w);
        const float rstd = __builtin_amdgcn_rsqf(wave_sum(ss) * (1.0f / DM) + EPS);
#pragma unroll
        for (int j = 0; j < 4; ++j)
#pragma unroll
            for (int hh = 0; hh < 2; ++hh) { const int col = (C.lane + 64 * j) * 8 + 4 * hh; *(f32x4*)(out + (size_t)r * DM + col) = v[2 * j + hh] * rstd * *(const f32x4*)(g + col); }
    }
}
__device__ __forceinline__ void phase_x_to_bf16(const Ctx& C, const float* x, bf16* X) {
    const size_t gt = (size_t)C.bid * NTHR + C.tid, NT = (size_t)C.G * NTHR;
#pragma unroll 4
    for (size_t i = gt; i < (size_t)M * DM / 8; i += NT) { const f32x4 a = *(const f32x4*)(x + i * 8), b = *(const f32x4*)(x + i * 8 + 4);
        v4u w; w.x = pg8::res_pk(a.x, a.y); w.y = pg8::res_pk(a.z, a.w); w.z = pg8::res_pk(b.x, b.y); w.w = pg8::res_pk(b.z, b.w); *(v4u*)(X + pg8::xblk_off((int)(i / (DM / 8)), (int)(i % (DM / 8)) * 8, DM)) = w; }
}

constexpr int LDT = 136;
#define LDS_BAR() do { asm volatile("s_waitcnt lgkmcnt(0)" ::: "memory"); __builtin_amdgcn_s_barrier(); asm volatile("" ::: "memory"); } while (0)
__device__ __forceinline__ float ret_log_g(int h) { return log1pf(-exp2f(-5.0f - (float)h)); }
__device__ __forceinline__ f32x4 mfma16(bf16x8 a, bf16x8 b, f32x4 c) { return __builtin_amdgcn_mfma_f32_16x16x32_bf16(a, b, c, 0, 0, 0); }

__device__ __forceinline__ int fresh_tid(int tid) { asm volatile("" : "+v"(tid)); return tid; }

template <int CHUNKS, bool BLK> __device__ __forceinline__ void tile_jc(int it, int& j, int& c8) {
    if constexpr (BLK) { constexpr int G = CHUNKS / 4; const int sub = it >> 6; j = (sub / G) * 16 + ((it & 63) >> 2); c8 = ((sub % G) * 4 + (it & 3)) * 8; }
    else { j = it / CHUNKS; c8 = (it % CHUNKS) * 8; }
}
template <int TOTAL, int CHUNKS, bool BLK = false>
struct RawTile {
    static constexpr int NV = (TOTAL + NTHR - 1) / NTHR;
    static_assert(!BLK || (CHUNKS % 4 == 0 && TOTAL % 64 == 0), "blocked tiles are whole 16 x 32 sub-blocks");
    v4u v[NV];
    __device__ __forceinline__ void issue(const bf16* src, size_t spitch, int tid) {
#pragma unroll
        for (int k = 0; k < NV; ++k) { const int it = tid + k * NTHR;
            if ((TOTAL % NTHR == 0) || it < TOTAL) { if constexpr (BLK) v[k] = *(const v4u*)(src + (size_t)it * 8); else { int j, c8; tile_jc<CHUNKS, false>(it, j, c8); v[k] = *(const v4u*)(src + (size_t)j * spitch + c8); } } }
    }
    __device__ __forceinline__ void store(LAS bf16* dst, int ld, int tid) const {
#pragma unroll
        for (int k = 0; k < NV; ++k) { const int it = tid + k * NTHR;
            if ((TOTAL % NTHR == 0) || it < TOTAL) { int j, c8; tile_jc<CHUNKS, BLK>(it, j, c8); *(LAS v4u*)(dst + j * ld + c8) = v[k]; } }
    }
};

struct RetARaw { RawTile<2048, 16, true> k, v; };
__device__ __forceinline__ void retA_issue(RetARaw& R, const P& p, int item, int tid) {
    const int n = item % RNC, bh = item / RNC; const size_t to = ((size_t)bh * SEQ + n * RC) * RD;
    R.k.issue(p.Z + ZO_K + to, RD, tid); R.v.issue(p.Z + ZO_V + to, RD, tid);
}
__device__ __forceinline__ void retA_store(const RetARaw& R, LAS bf16* Kt, LAS bf16* Vt, float lg, int tid) {
    R.k.store(Kt, LDT, tid);
#pragma unroll
    for (int k = 0; k < 4; ++k) { const int it = tid + k * NTHR; int j, c8; tile_jc<16, true>(it, j, c8); const float z = __expf((float)(RC - 1 - j) * lg);
        v4u a = R.v.v[k];
#pragma unroll
        for (int e = 0; e < 4; ++e) a[e] = pk2(bflo(a[e]) * z, bfhi(a[e]) * z);
        *(LAS v4u*)(Vt + j * LDT + c8) = a; }
}
__device__ __forceinline__ void retA_compute(const LAS bf16* Kt, const LAS bf16* Vt, bf16* U, int wave, int lane) {
    const int g = lane >> 4, c = lane & 15;
    bf16x8 bv[4], ak[2][4];
#pragma unroll
    for (int s = 0; s < 4; ++s) { bv[s] = ldfrag<true>(Vt, LDT, wave * 16, 32 * s, lane); ak[0][s] = ldfrag<true>(Kt, LDT, 0, 32 * s, lane); }
#pragma unroll
    for (int db = 0; db < 8; ++db) {
        if (db + 1 < 8) {
#pragma unroll
            for (int s = 0; s < 4; ++s) ak[(db + 1) & 1][s] = ldfrag<true>(Kt, LDT, (db + 1) * 16, 32 * s, lane); }
        __builtin_amdgcn_sched_barrier(0);
        f32x4 acc = {0.f, 0.f, 0.f, 0.f};
#pragma unroll
        for (int s = 0; s < 4; ++s) acc = mfma16(ak[db & 1][s], bv[s], acc);
        v2u o; o.x = pk2(acc[0], acc[1]); o.y = pk2(acc[2], acc[3]);
        *(v2u*)(U + (wave * 16 + c) * RD + db * 16 + 4 * g) = o;
        __builtin_amdgcn_sched_barrier(0);
    }
}
__device__ __forceinline__ void phase_retA(const Ctx& C, const P& p) {
    constexpr int N = BATCH * RH * RNC;
    LAS bf16* Kt = (LAS bf16*)C.lds; LAS bf16* Vt = Kt + 128 * LDT;
    int it = C.bid; if (it >= N) return;
    RetARaw R; retA_issue(R, p, it, C.tid);
    for (;;) {
        const float lg = ret_log_g((it / RNC) % RH);
        retA_store(R, Kt, Vt, lg, fresh_tid(C.tid));
        LDS_BAR();
        const int nx = it + C.G;
        if (nx < N) retA_issue(R, p, nx, fresh_tid(C.tid));
        retA_compute(Kt, Vt, p.uret + (size_t)it * RD * RD, C.wave, fresh_tid(C.tid) & 63);
        LDS_BAR();
        if (nx >= N) break;
        it = nx;
    }
}

struct RetBRaw { RawTile<2048, 16, true> q, k, v; RawTile<2048, 16> r; };
__device__ __forceinline__ void retB_issue(RetBRaw& R, const P& p, int item, int tid) {
    const int n = item % RNC, bh = item / RNC; const size_t to = ((size_t)bh * SEQ + n * RC) * RD;
    R.q.issue(p.Z + ZO_Q + to, RD, tid); R.k.issue(p.Z + ZO_K + to, RD, tid);
    R.v.issue(p.Z + ZO_V + to, RD, tid); R.r.issue(p.rprev + (size_t)item * RD * RD, RD, tid);
}
constexpr int OLD = 132;
static_assert(128 * OLD * 4 <= 2 * 128 * LDT * 2, "staged output fits over Q and P");
__device__ __forceinline__ void retB_compute(LAS bf16* Qt, LAS bf16* Kt, LAS bf16* Vt, LAS bf16* Rt, const P& p, int item, int w, int lane, int tid) {
    const int n = item % RNC, h = (item / RNC) % RH, b = item / (RNC * RH);
    const int t0 = b * SEQ + n * RC; const float lg = ret_log_g(h); const float scale = 0.08838834764831845f;
    const int g = lane >> 4, c = lane & 15;
    f32x4 s[8];
    {
        bf16x8 a[4], bq[2][4];
#pragma unroll
        for (int s4 = 0; s4 < 4; ++s4) a[s4] = ldfrag<false>(Kt, LDT, w * 16, 32 * s4, lane);
        if (w == 0) {
#pragma unroll
            for (int s4 = 0; s4 < 4; ++s4) bq[0][s4] = ldfrag<false>(Qt, LDT, 0, 32 * s4, lane); }
#pragma unroll
        for (int ib = 0; ib < 8; ++ib) {
            if (ib + 1 < 8 && ib + 1 >= w) {
#pragma unroll
                for (int s4 = 0; s4 < 4; ++s4) bq[(ib + 1) & 1][s4] = ldfrag<false>(Qt, LDT, (ib + 1) * 16, 32 * s4, lane); }
            __builtin_amdgcn_sched_barrier(0);
            s[ib] = (f32x4){0.f, 0.f, 0.f, 0.f};
            if (ib >= w) {
#pragma unroll
                for (int s4 = 0; s4 < 4; ++s4) s[ib] = mfma16(a[s4], bq[ib & 1][s4], s[ib]); }
            __builtin_amdgcn_sched_barrier(0);
        }
    }
    RawTile<2048, 16, true> G; G.issue(p.Z + ZO_G + ((size_t)(item / RNC) * SEQ + n * RC) * RD, RD, tid);
    LDS_BAR();
    LAS bf16* Pt = Kt;
    {
        float rj[4]; const float ec = scale * __expf((float)c * lg);
#pragma unroll
        for (int r = 0; r < 4; ++r) rj[r] = __expf(-(float)(w * 16 + 4 * g + r) * lg);
#pragma unroll
        for (int ib = 0; ib < 8; ++ib) {
            const float ci = ec * __expf((float)(16 * ib) * lg); float v[4];
#pragma unroll
            for (int r = 0; r < 4; ++r) { v[r] = s[ib][r] * ci * rj[r]; if (ib == w && c < 4 * g + r) v[r] = 0.f; }
            v2u o; o.x = pk2(v[0], v[1]); o.y = pk2(v[2], v[3]);
            *(LAS v2u*)(Pt + (ib * 16 + c) * LDT + w * 16 + 4 * g) = o;
        }
    }
    LDS_BAR();
    f32x4 o[8];
    {
        const int smax = w >> 1;
        bf16x8 ap[4], aq[4];
#pragma unroll
        for (int s4 = 0; s4 < 4; ++s4) { aq[s4] = ldfrag<false>(Qt, LDT, w * 16, 32 * s4, lane); ap[s4] = (bf16x8){0, 0, 0, 0, 0, 0, 0, 0}; if (s4 <= smax) ap[s4] = ldfrag<false>(Pt, LDT, w * 16, 32 * s4, lane); }
        float xi[4];
#pragma unroll
        for (int r = 0; r < 4; ++r) xi[r] = scale * __expf((float)(w * 16 + 4 * g + r + 1) * lg);
        bf16x8 fv[4], fr[2][4];
#pragma unroll
        for (int s4 = 0; s4 < 4; ++s4) fr[0][s4] = ldfrag<false>(Rt, LDT, 0, 32 * s4, lane);
#pragma unroll
        for (int eb = 0; eb < 8; ++eb) {
#pragma unroll
            for (int s4 = 0; s4 < 4; ++s4) { fv[s4] = (bf16x8){0, 0, 0, 0, 0, 0, 0, 0}; if (s4 <= smax) fv[s4] = ldfrag<true>(Vt, LDT, eb * 16, 32 * s4, lane); }
            if (eb + 1 < 8) {
#pragma unroll
                for (int s4 = 0; s4 < 4; ++s4) fr[(eb + 1) & 1][s4] = ldfrag<false>(Rt, LDT, (eb + 1) * 16, 32 * s4, lane); }
            __builtin_amdgcn_sched_barrier(0);
            f32x4 in = {0.f, 0.f, 0.f, 0.f}, cr = {0.f, 0.f, 0.f, 0.f};
#pragma unroll
            for (int s4 = 0; s4 < 4; ++s4) cr = mfma16(aq[s4], fr[eb & 1][s4], cr);
#pragma unroll
            for (int s4 = 0; s4 < 4; ++s4) { if (s4 <= smax) in = mfma16(ap[s4], fv[s4], in); }
#pragma unroll
            for (int r = 0; r < 4; ++r) o[eb][r] = in[r] + xi[r] * cr[r];
            __builtin_amdgcn_sched_barrier(0);
        }
    }
#pragma unroll
    for (int r = 0; r < 4; ++r) {
        float sm = 0.f;
#pragma unroll
        for (int eb = 0; eb < 8; ++eb) sm += o[eb][r];
        const float mean = sum16(sm) * (1.0f / RD);
        float q = 0.f;
#pragma unroll
        for (int eb = 0; eb < 8; ++eb) { const float d = o[eb][r] - mean; q += d * d; }
        const float rstd = 1.0f / sqrtf(sum16(q) * (1.0f / RD) + EPS);
#pragma unroll
        for (int eb = 0; eb < 8; ++eb) o[eb][r] = (o[eb][r] - mean) * rstd;
    }
    LDS_BAR();
    LAS float* Ot = (LAS float*)Qt;
#pragma unroll
    for (int r = 0; r < 4; ++r)
#pragma unroll
        for (int eb = 0; eb < 8; ++eb) Ot[(w * 16 + 4 * g + r) * OLD + eb * 16 + c] = o[eb][r];
    LDS_BAR();
#pragma unroll
    for (int k = 0; k < 4; ++k) { const int it = tid + k * NTHR; int j, c8; tile_jc<16, true>(it, j, c8);
        const f32x4 y0 = *(const LAS f32x4*)(Ot + j * OLD + c8), y1 = *(const LAS f32x4*)(Ot + j * OLD + c8 + 4); const v4u gt = G.v[k];
        v4u ov; ov.x = pk2(y0.x * bflo(gt.x), y0.y * bfhi(gt.x)); ov.y = pk2(y0.z * bflo(gt.y), y0.w * bfhi(gt.y)); ov.z = pk2(y1.x * bflo(gt.z), y1.y * bfhi(gt.z)); ov.w = pk2(y1.z * bflo(gt.w), y1.w * bfhi(gt.w));
        *(v4u*)(p.MIX + (size_t)(t0 + j) * DM + MIX_RET + h * RD + c8) = ov; }
}
__device__ __forceinline__ void phase_retB(const Ctx& C, const P& p) {
    constexpr int N = BATCH * RH * RNC;
    LAS bf16* Qt = (LAS bf16*)C.lds; LAS bf16* Kt = Qt + 128 * LDT; LAS bf16* Vt = Kt + 128 * LDT; LAS bf16* Rt = Vt + 128 * LDT;
    int it = C.bid; if (it >= N) return;
    RetBRaw R; retB_issue(R, p, it, C.tid);
    for (;;) {
        { const int t = fresh_tid(C.tid); R.q.store(Qt, LDT, t); R.k.store(Kt, LDT, t); R.v.store(Vt, LDT, t); R.r.store(Rt, LDT, t); }
        LDS_BAR();
        const int nx = it + C.G;
        if (nx < N) retB_issue(R, p, nx, fresh_tid(C.tid));
        { const int t = fresh_tid(C.tid); retB_compute(Qt, Kt, Vt, Rt, p, it, C.wave, t & 63, t); }
        LDS_BAR();
        if (nx >= N) break;
        it = nx;
    }
}

constexpr int BLD = 100, KLD = 104, VLD = 200, PLD = 72, GZLD = 32;
constexpr int G_BC = 0, G_GZ = G_BC + GC * BLD * 4  , G_SEG = G_GZ + GC * GZLD * 2  , G_WG = G_SEG + 4 * GDK * 4  , G_QD = G_WG + GDK * GZLD * 2  ,
              G_KI = G_QD + GC * KLD * 2  , G_V = G_KI + GC * KLD * 2  , G_SP = G_V + GC * VLD * 2  , G_P = G_SP + GDV * KLD * 2  , G_SSQ = G_P + GC * PLD * 2  ,
              G_END = G_SSQ + GC * 2 * 4;
static_assert(G_END <= RING_BYTES && (G_GZ % 16) == 0 && (G_WG % 16) == 0 && (G_QD % 16) == 0 && (G_KI % 16) == 0 && (G_V % 16) == 0 && (G_SP % 16) == 0 && (G_P % 16) == 0, "GLA LDS map");
struct GlaGateRaw { v4u gz; float wv[4]; float bias[3]; };
__device__ __forceinline__ void glaG_issue(GlaGateRaw& R, const P& p, int l, int t0, int h, int tid, int wave, int lane) {
    if (tid < 128) R.gz = *(const v4u*)(p.Z + ZO_GZ + (size_t)t0 * 16 + tid * 8);
    if (tid < 4 * GDK) { const int d = tid % GDK, rq = tid / GDK;
#pragma unroll
        for (int r = 0; r < 4; ++r) R.wv[r] = p.w_gate[((size_t)l * 16 + 4 * rq + r) * (GH * GDK) + h * GDK + d]; }
#pragma unroll
    for (int i = 0; i < 3; ++i) R.bias[i] = p.b_gate[l * (GH * GDK) + h * GDK + ((wave & 1) * 3 + i) * 16 + (lane & 15)];
}
__device__ __forceinline__ void gla_gates(const Ctx& C, const GlaGateRaw& R) {
    LAS float* bc = (LAS float*)(C.lds + G_BC); LAS bf16* gzs = (LAS bf16*)(C.lds + G_GZ); LAS float* seg = (LAS float*)(C.lds + G_SEG); LAS bf16* wgt = (LAS bf16*)(C.lds + G_WG);
    if (C.tid < 128) *(LAS v4u*)(gzs + (C.tid >> 1) * GZLD + (C.tid & 1) * 8) = R.gz;
    if (C.tid < 4 * GDK) { v2u o; o.x = pk2(R.wv[0], R.wv[1]); o.y = pk2(R.wv[2], R.wv[3]); *(LAS v2u*)(wgt + (C.tid % GDK) * GZLD + 4 * (C.tid / GDK)) = o; }
    LDS_BAR();
    {
        const int g = C.lane >> 4, c = C.lane & 15, jb = C.wave >> 1;
        const bf16x8 a = ldfrag<false>(gzs, GZLD, jb * 16, 0, C.lane);
#pragma unroll
        for (int i = 0; i < 3; ++i) { const int db = (C.wave & 1) * 3 + i;
            const f32x4 x = mfma16(a, ldfrag<false>(wgt, GZLD, db * 16, 0, C.lane), (f32x4){0.f, 0.f, 0.f, 0.f});
#pragma unroll
            for (int r = 0; r < 4; ++r) { const float xg = x[r] + R.bias[i];
                bc[(jb * 16 + 4 * g + r) * BLD + db * 16 + c] = (fminf(xg, 0.f) - __logf(1.0f + __expf(-fabsf(xg)))) * (1.0f / 16.0f); }
        }
    }
    LDS_BAR();
    const int d = C.tid % GDK, sg = C.tid / GDK;
    float bl[16]; float run = 0.f;
    if (C.tid < 4 * GDK) {
#pragma unroll
        for (int jj = 0; jj < 16; ++jj) { run += bc[(sg * 16 + jj) * BLD + d]; bl[jj] = run; }
        seg[sg * GDK + d] = run;
    }
    LDS_BAR();
    if (C.tid < 4 * GDK) {
        float pre = 0.f;
        for (int s = 0; s < sg; ++s) pre += seg[s * GDK + d];
#pragma unroll
        for (int jj = 0; jj < 16; ++jj) bc[(sg * 16 + jj) * BLD + d] = pre + bl[jj];
    }
    LDS_BAR();
}
__device__ __forceinline__ void gla_store_qk(const Ctx& C, LAS bf16* dst, const RawTile<768, 12, true>& R, float mul, float sgn, bool addlast) {
    const LAS float* bc = (const LAS float*)(C.lds + G_BC);
#pragma unroll
    for (int k = 0; k < 2; ++k) { const int it = C.tid + k * NTHR;
        if (it < 768) { int j, c8; tile_jc<12, true>(it, j, c8); const v4u a = R.v[k]; v4u o;
#pragma unroll
            for (int e = 0; e < 4; ++e) {
                const int d0 = c8 + 2 * e;
                const float e0 = sgn * bc[j * BLD + d0] + (addlast ? bc[63 * BLD + d0] : 0.f), e1 = sgn * bc[j * BLD + d0 + 1] + (addlast ? bc[63 * BLD + d0 + 1] : 0.f);
                o[e] = pk2(bflo(a[e]) * mul * __expf(e0), bfhi(a[e]) * mul * __expf(e1));
            }
            *(LAS v4u*)(dst + j * KLD + c8) = o; } }
}
struct GlaARaw { GlaGateRaw gt; RawTile<768, 12, true> k; RawTile<1536, 24, true> v; };
__device__ __forceinline__ void glaA_issue(GlaARaw& R, const P& p, int l, int item, int tid) {
    const int n = item % GNC, h = (item / GNC) % GH, b = item / (GNC * GH); const int t0 = b * SEQ + n * GC;
    glaG_issue(R.gt, p, l, t0, h, tid, __builtin_amdgcn_readfirstlane(tid >> 6), tid & 63);
    const size_t tr = (size_t)(b * GH + h) * SEQ + n * GC;
    R.k.issue(p.Z + ZO_GK + tr * GDK, GDK, tid); R.v.issue(p.Z + ZO_GV + tr * GDV, GDV, tid);
}
__device__ __forceinline__ void phase_glaA(const Ctx& Cin, const P& p, int l) {
    constexpr int N = BATCH * GH * GNC;
    LAS bf16* kst = (LAS bf16*)(Cin.lds + G_KI); LAS bf16* Vt = (LAS bf16*)(Cin.lds + G_V);
    int it = Cin.bid; if (it >= N) return;
    for (int i = Cin.tid; i < (G_QD - G_GZ) / 4; i += NTHR) ((LAS unsigned*)(Cin.lds + G_GZ))[i] = 0u;
    LDS_BAR();
    GlaARaw R; glaA_issue(R, p, l, it, Cin.tid);
    for (;;) {
        Ctx C = Cin; C.tid = fresh_tid(Cin.tid); C.lane = C.tid & 63;
        const int g = C.lane >> 4, c = C.lane & 15;
        gla_gates(C, R.gt);
        gla_store_qk(C, kst, R.k, 1.0f, -1.0f, true);
        R.v.store(Vt, VLD, C.tid);
        if (C.tid < GDK) p.gch[(size_t)it * GDK + C.tid] = __expf(((const LAS float*)(C.lds + G_BC))[63 * BLD + C.tid]);
#pragma unroll
        for (int k = 0; k < 3; ++k) { const int i2 = C.tid + k * NTHR, j = i2 / 24, c4 = (i2 % 24) * 4;
            *(f32x4*)(p.gb + (size_t)it * (GC * GDK) + j * GDK + c4) = *(const LAS f32x4*)((const LAS float*)(C.lds + G_BC) + j * BLD + c4); }
        LDS_BAR();
        const int nx = it + C.G;
        if (nx < N) glaA_issue(R, p, l, nx, C.tid);
        bf16* U = p.ugla + (size_t)it * GDV * GDK;
        {
            bf16x8 fk[2][2], fvv[2][2];
#define GLAA_LOADF(ix, tt_) do { const int t_ = C.wave * 9 + (tt_), eb_ = t_ / 6, db_ = t_ % 6; _Pragma("unroll") for (int s = 0; s < 2; ++s) { \
                fk[ix][s] = ldfrag<true>(kst, KLD, db_ * 16, 32 * s, C.lane); fvv[ix][s] = ldfrag<true>(Vt, VLD, eb_ * 16, 32 * s, C.lane); } } while (0)
            GLAA_LOADF(0, 0);
#pragma unroll
            for (int tt = 0; tt < 9; ++tt) {
                if (tt + 1 < 9) GLAA_LOADF((tt + 1) & 1, tt + 1);
                __builtin_amdgcn_sched_barrier(0);
                const int t = C.wave * 9 + tt, eb = t / 6, db = t % 6;
                f32x4 acc = {0.f, 0.f, 0.f, 0.f};
#pragma unroll
                for (int s = 0; s < 2; ++s) acc = mfma16(fk[tt & 1][s], fvv[tt & 1][s], acc);
                v2u o; o.x = pk2(acc[0], acc[1]); o.y = pk2(acc[2], acc[3]);
                *(v2u*)(U + (eb * 16 + c) * GDK + db * 16 + 4 * g) = o;
                __builtin_amdgcn_sched_barrier(0);
            }
#undef GLAA_LOADF
        }
        LDS_BAR();
        if (nx >= N) break;
        it = nx;
    }
}
struct GlaBRaw { f32x4 gb[3]; RawTile<768, 12, true> q, k; RawTile<1536, 24, true> v; RawTile<2304, 12> sp; };
__device__ __forceinline__ void glaB_issue(GlaBRaw& R, const P& p, int l, int item, int tid) {
    const int n = item % GNC, h = (item / GNC) % GH, b = item / (GNC * GH); const int t0 = b * SEQ + n * GC;
#pragma unroll
    for (int k = 0; k < 3; ++k) { const int i2 = tid + k * NTHR; R.gb[k] = *(const f32x4*)(p.gb + (size_t)item * (GC * GDK) + (i2 / 24) * GDK + (i2 % 24) * 4); }
    (void)t0; (void)l;
    const size_t tr = (size_t)(b * GH + h) * SEQ + n * GC;
    R.q.issue(p.Z + ZO_GQ + tr * GDK, GDK, tid); R.k.issue(p.Z + ZO_GK + tr * GDK, GDK, tid);
    R.v.issue(p.Z + ZO_GV + tr * GDV, GDV, tid); R.sp.issue(p.sprev + (size_t)item * GDV * GDK, GDK, tid);
}
__device__ __forceinline__ void phase_glaB(const Ctx& Cin, const P& p, int l) {
    constexpr int N = BATCH * GH * GNC;
    LAS bf16* qd = (LAS bf16*)(Cin.lds + G_QD); LAS bf16* ki = (LAS bf16*)(Cin.lds + G_KI); LAS bf16* Vt = (LAS bf16*)(Cin.lds + G_V);
    LAS bf16* Sp = (LAS bf16*)(Cin.lds + G_SP); LAS bf16* Pt = (LAS bf16*)(Cin.lds + G_P); LAS float* ssq = (LAS float*)(Cin.lds + G_SSQ);
    int it = Cin.bid; if (it >= N) return;
    GlaBRaw R; glaB_issue(R, p, l, it, Cin.tid);
    for (;;) {
        Ctx C = Cin; C.tid = fresh_tid(Cin.tid); C.lane = C.tid & 63;
        const int g = C.lane >> 4, c = C.lane & 15, w = C.wave;
        const int n = it % GNC, h = (it / GNC) % GH, b = it / (GNC * GH); const int t0 = b * SEQ + n * GC;
#pragma unroll
        for (int k = 0; k < 3; ++k) { const int i2 = C.tid + k * NTHR; *(LAS f32x4*)((LAS float*)(C.lds + G_BC) + (i2 / 24) * BLD + (i2 % 24) * 4) = R.gb[k]; }
        LDS_BAR();
        gla_store_qk(C, qd, R.q, 0.10206207261596577f  , 1.0f, false);
        gla_store_qk(C, ki, R.k, 1.0f, -1.0f, false);
        R.v.store(Vt, VLD, C.tid); R.sp.store(Sp, KLD, C.tid);
        LDS_BAR();
        const int nx = it + C.G;
        if (nx < N) glaB_issue(R, p, l, nx, C.tid);
        const int ib2 = w >> 1, half = w & 1;
        unsigned short gl[6][4];
#pragma unroll
        for (int r = 0; r < 4; ++r)
#pragma unroll
            for (int ee = 0; ee < 6; ++ee) gl[ee][r] = p.Z[ZO_GR + ((size_t)(b * GH + h) * SEQ + n * GC) * GDV + (size_t)((ib2 * 6 + (((half * 6 + ee) * 16) >> 5)) * 512 + (4 * g + r) * 32 + ((((half * 6 + ee) * 16) & 31) + c))];
        {
            const int jb = w >> 1;
            bf16x8 a[3];
#pragma unroll
            for (int s = 0; s < 3; ++s) a[s] = ldfrag<false>(ki, KLD, jb * 16, 32 * s, C.lane);
#pragma unroll
            for (int ii = 0; ii < 2; ++ii) {
                const int ib = (w & 1) * 2 + ii;
                f32x4 sc = {0.f, 0.f, 0.f, 0.f};
                if (ib >= jb) {
#pragma unroll
                    for (int s = 0; s < 3; ++s) sc = mfma16(a[s], ldfrag<false>(qd, KLD, ib * 16, 32 * s, C.lane), sc); }
                const int i = ib * 16 + c; float v[4];
#pragma unroll
                for (int r = 0; r < 4; ++r) { const int j = jb * 16 + 4 * g + r; v[r] = (i >= j) ? sc[r] : 0.f; }
                v2u o; o.x = pk2(v[0], v[1]); o.y = pk2(v[2], v[3]);
                *(LAS v2u*)(Pt + i * PLD + jb * 16 + 4 * g) = o;
            }
        }
        LDS_BAR();
        {
            f32x4 o[6];
            bf16x8 ap[2], aq[3];
#pragma unroll
            for (int s = 0; s < 2; ++s) ap[s] = ldfrag<false>(Pt, PLD, ib2 * 16, 32 * s, C.lane);
#pragma unroll
            for (int s = 0; s < 3; ++s) aq[s] = ldfrag<false>(qd, KLD, ib2 * 16, 32 * s, C.lane);
            bf16x8 fv2[2][2], fs2[2][3];
#define GLAB_LOADF(ix, ee_) do { const int eb_ = half * 6 + (ee_); _Pragma("unroll") for (int s = 0; s < 2; ++s) fv2[ix][s] = ldfrag<true>(Vt, VLD, eb_ * 16, 32 * s, C.lane); \
                _Pragma("unroll") for (int s = 0; s < 3; ++s) fs2[ix][s] = ldfrag<false>(Sp, KLD, eb_ * 16, 32 * s, C.lane); } while (0)
            GLAB_LOADF(0, 0);
#pragma unroll
            for (int ee = 0; ee < 6; ++ee) {
                if (ee + 1 < 6) GLAB_LOADF((ee + 1) & 1, ee + 1);
                __builtin_amdgcn_sched_barrier(0);
                o[ee] = (f32x4){0.f, 0.f, 0.f, 0.f};
#pragma unroll
                for (int s = 0; s < 2; ++s) o[ee] = mfma16(ap[s], fv2[ee & 1][s], o[ee]);
#pragma unroll
                for (int s = 0; s < 3; ++s) o[ee] = mfma16(aq[s], fs2[ee & 1][s], o[ee]);
                __builtin_amdgcn_sched_barrier(0);
            }
#undef GLAB_LOADF
#pragma unroll
            for (int r = 0; r < 4; ++r) {
                float q = 0.f;
#pragma unroll
                for (int ee = 0; ee < 6; ++ee) q += o[ee][r] * o[ee][r];
                q = sum16(q);
                if (c == 0) ssq[(ib2 * 16 + 4 * g + r) * 2 + half] = q;
            }
            LDS_BAR();
#pragma unroll
            for (int r = 0; r < 4; ++r) {
                const int i = ib2 * 16 + 4 * g + r;
                const float rstd = 1.0f / sqrtf((ssq[i * 2] + ssq[i * 2 + 1]) * (1.0f / GDV) + EPS);
                const size_t tok = (size_t)(t0 + i);
#pragma unroll
                for (int ee = 0; ee < 6; ++ee) p.MIX[tok * DM + MIX_GLA + h * GDV + (half * 6 + ee) * 16 + c] = (bf16)f2bf(o[ee][r] * rstd * bf2f(gl[ee][r]));
            }
        }
        LDS_BAR();
        if (nx >= N) break;
        it = nx;
    }
}

struct PoolRaw { RawTile<2304, 16, true> u; f32x4 w[8]; };
__device__ __forceinline__ void pool_issue(PoolRaw& R, const P& p, int l, int item, int tid) {
    const int g4 = item % 4, tt = (item / 4) % (SEQ / 128), b = item / (4 * (SEQ / 128)); const int t0 = b * SEQ + tt * 128;
    const bf16* ub = p.Z + ZO_P + ((size_t)(b * 4 + g4) * SEQ + tt * 128 - 16) * 128;
#pragma unroll
    for (int k = 0; k < 5; ++k) { const int it = tid + k * NTHR;
        if (it < 2304) R.u.v[k] = *(const v4u*)(ub + (size_t)it * 8 + ((tt == 0 && it < 256) ? 16 * 128 : 0)); }
    (void)t0;
    const float* wsrc = p.w_pool + ((size_t)l * 4 + g4) * 128 * 128;
#pragma unroll
    for (int k = 0; k < 8; ++k) { const int it = tid + k * NTHR; R.w[k] = *(const f32x4*)(wsrc + (it >> 5) * 128 + (it & 31) * 4); }
}
__device__ __forceinline__ void phase_pool(const Ctx& Cin, const P& p, int l) {
    constexpr int N = BATCH * (SEQ / 128) * 4;
    LAS bf16* U = (LAS bf16*)Cin.lds; LAS bf16* Pl = U + 144 * LDT; LAS bf16* Wp = Pl + 128 * LDT;
    int it = Cin.bid; if (it >= N) return;
    PoolRaw R; pool_issue(R, p, l, it, Cin.tid);
    for (;;) {
        Ctx C = Cin; C.tid = fresh_tid(Cin.tid); C.lane = C.tid & 63;
        const int g = C.lane >> 4, c = C.lane & 15, tb = C.wave;
        const int g4 = it % 4, tt = (it / 4) % (SEQ / 128), b = it / (4 * (SEQ / 128)); const int t0 = b * SEQ + tt * 128, win = 2 << g4;
#pragma unroll
        for (int k = 0; k < 5; ++k) { const int i2 = C.tid + k * NTHR;
            if (i2 < 2304) { int rr, c8; tile_jc<16, true>(i2, rr, c8); v4u a = R.u.v[k]; if (tt == 0 && rr < 16) a = (v4u){0u, 0u, 0u, 0u}; *(LAS v4u*)(U + rr * LDT + c8) = a; } }
#pragma unroll
        for (int k = 0; k < 8; ++k) { const int i2 = C.tid + k * NTHR; const int cc = i2 >> 5, d4 = (i2 & 31) * 4;
            v2u o; o.x = pk2(R.w[k].x, R.w[k].y); o.y = pk2(R.w[k].z, R.w[k].w); *(LAS v2u*)(Wp + cc * LDT + d4) = o; }
        LDS_BAR();
        const int nx = it + C.G;
        if (nx < N) pool_issue(R, p, l, nx, C.tid);
        for (int i2 = C.tid; i2 < 128 * 16; i2 += NTHR) {
            const int t = i2 >> 4, c8 = (i2 & 15) * 8;
            const int pos = tt * 128 + t; const int cnt = (pos + 1 < win) ? pos + 1 : win;
            float s[8];
#pragma unroll
            for (int e = 0; e < 8; ++e) s[e] = 0.f;
            for (int k = 0; k < win; ++k) {
                const v4u a = *(const LAS v4u*)(U + (16 + t - k) * LDT + c8);
#pragma unroll
                for (int e = 0; e < 4; ++e) { s[2 * e] += bflo(a[e]); s[2 * e + 1] += bfhi(a[e]); }
            }
            const v4u a = *(const LAS v4u*)(U + (16 + t) * LDT + c8);
            const float inv = 1.0f / (float)cnt;
            v4u o;
#pragma unroll
            for (int e = 0; e < 4; ++e) o[e] = pk2(s[2 * e] * inv - bflo(a[e]), s[2 * e + 1] * inv - bfhi(a[e]));
            *(LAS v4u*)(Pl + t * LDT + c8) = o;
        }
        LDS_BAR();
        {
            bf16x8 a[4];
#pragma unroll
            for (int s = 0; s < 4; ++s) a[s] = ldfrag<false>(Pl, LDT, tb * 16, 32 * s, C.lane);
            bf16x8 fw[2][4];
#pragma unroll
            for (int s = 0; s < 4; ++s) fw[0][s] = ldfrag<true>(Wp, LDT, 0, 32 * s, C.lane);
#pragma unroll
            for (int db = 0; db < 8; ++db) {
                if (db + 1 < 8) {
#pragma unroll
                    for (int s = 0; s < 4; ++s) fw[(db + 1) & 1][s] = ldfrag<true>(Wp, LDT, (db + 1) * 16, 32 * s, C.lane); }
                __builtin_amdgcn_sched_barrier(0);
                f32x4 acc = {0.f, 0.f, 0.f, 0.f};
#pragma unroll
                for (int s = 0; s < 4; ++s) acc = mfma16(a[s], fw[db & 1][s], acc);
                const int d = db * 16 + c; const float sp = p.s_pool[l * 512 + g4 * 128 + d];
#pragma unroll
                for (int r = 0; r < 4; ++r) p.MIX[(size_t)(t0 + tb * 16 + 4 * g + r) * DM + MIX_POOL + g4 * 128 + d] = (bf16)f2bf(acc[r] * sp);
                __builtin_amdgcn_sched_barrier(0);
            }
        }
        LDS_BAR();
        if (nx >= N) break;
        it = nx;
    }
}

__device__ __forceinline__ void phase_scan(const Ctx& C, const P& p) {
    const int gt = C.bid * NTHR + C.tid, NT = C.G * NTHR;
    constexpr int RQ = RD * RD / 4, NRET = BATCH * RH * RQ;
    constexpr int GQn = GDV * GDK / 4, NGLA = BATCH * GH * GQn;
    constexpr int NW = NGLA + NRET / 2;
    for (int w = gt; w < NW; w += NT) {
        if (w < NGLA) {
            const int chain = w / GQn, q = w % GQn, d = (q * 4) % GDK;
            f32x4 S = {0.f, 0.f, 0.f, 0.f};
#pragma unroll 8
            for (int n = 0; n < GNC; ++n) {
                const size_t base = ((size_t)(chain * GNC + n) * GQn + q) * 4;
                v2u o; o.x = pk2(S.x, S.y); o.y = pk2(S.z, S.w);
                *(v2u*)(p.sprev + base) = o;
                const v2u ub = *(const v2u*)(p.ugla + base); const f32x4 u = {bflo(ub.x), bfhi(ub.x), bflo(ub.y), bfhi(ub.y)};
                const f32x4 gg = *(const f32x4*)(p.gch + (size_t)(chain * GNC + n) * GDK + d);
                S = S * gg + u;
            }
        } else {
            const int it0 = (w - NGLA) * 2;
            const int chain = it0 / RQ, q = it0 % RQ, h = chain % RH;
            const float gc = __expf((float)RC * ret_log_g(h));
            f32x4 R0 = {0.f, 0.f, 0.f, 0.f}, R1 = R0;
#pragma unroll 8
            for (int n = 0; n < RNC; ++n) {
                const size_t base = ((size_t)(chain * RNC + n) * RQ + q) * 4;
                v4u o; o.x = pk2(R0.x, R0.y); o.y = pk2(R0.z, R0.w); o.z = pk2(R1.x, R1.y); o.w = pk2(R1.z, R1.w);
                *(v4u*)(p.rprev + base) = o;
                const v4u ub = *(const v4u*)(p.uret + base);
                R0 = R0 * gc + (f32x4){bflo(ub.x), bfhi(ub.x), bflo(ub.y), bfhi(ub.y)};
                R1 = R1 * gc + (f32x4){bflo(ub.z), bfhi(ub.z), bflo(ub.w), bfhi(ub.w)};
            }
        }
    }
}

#ifndef WGM_IN
#define WGM_IN 4
#define WGM_OUT 4
#define WGM_UP 4
#define WGM_DN 4
#endif
enum { PH_PRO = 0, PH_MODFIN = 1, PH_NORM1 = 2, PH_INPROJ = 3, PH_MIXA = 4, PH_SCAN = 5, PH_MIXB = 6, PH_OUTPROJ = 7, PH_NORM2 = 8, PH_UP = 9, PH_DOWN = 10, PH_FINAL = 11 };
struct Args { const float* in[15]; float* out; unsigned char* ws; int l_lo, l_hi, ph_lo, ph_hi, fused, pad; };

#define CAS __attribute__((address_space(4)))
__device__ __forceinline__ const CAS Args* kargs() { CAS void* k = (CAS void*)__builtin_amdgcn_kernarg_segment_ptr(); asm volatile("" : "+s"(k)); return (const CAS Args*)k; }
__device__ __forceinline__ P make_p(const Args& args, GAS unsigned char* ws) {
    P p;
    p.x = args.in[0]; p.c = args.in[1]; p.w_ada = args.in[2]; p.b_ada = args.in[3]; p.g_mix = args.in[4]; p.g_mlp = args.in[5]; p.w_in = args.in[6]; p.w_gate = args.in[7];
    p.b_gate = args.in[8]; p.w_pool = args.in[9]; p.s_pool = args.in[10]; p.w_out = args.in[11]; p.w_up = args.in[12]; p.w_down = args.in[13]; p.g_final = args.in[14];
    p.out = args.out;
    p.mod = (float*)(ws + WS_MOD); p.modp = (float*)(ws + WS_MODP); p.rot = (unsigned*)(ws + WS_COS); p.gch = (float*)(ws + WS_GCH); p.gb = (float*)(ws + WS_GB);
    p.X = (bf16*)(ws + WS_X); p.uret = (bf16*)(ws + WS_URET); p.ugla = (bf16*)(ws + WS_UGLA);
    p.win = (bf16*)(ws + WS_WIN); p.wout = (bf16*)(ws + WS_WOUT); p.wup = (bf16*)(ws + WS_WUP); p.wdn = (bf16*)(ws + WS_WDN);
    p.XN = (bf16*)(ws + WS_XN); p.Z = (bf16*)(ws + WS_Z); p.MIX = (bf16*)(ws + WS_MIX); p.H = (bf16*)(ws + WS_H); p.rprev = (bf16*)(ws + WS_RPREV); p.sprev = (bf16*)(ws + WS_SPREV);
    return p;
}
__device__ __forceinline__ Ctx make_ctx(LAS unsigned char* lds) {
    Ctx C; int tid = threadIdx.x; asm volatile("" : "+v"(tid));
    asm volatile("" : "+s"(lds));
    C.lds = lds; C.tid = tid; C.lane = tid & 63; C.wave = __builtin_amdgcn_readfirstlane(tid >> 6);
    int bid = blockIdx.x, G = gridDim.x; asm volatile("" : "+s"(bid), "+s"(G));
    C.bid = bid; C.G = G; return C;
}
__device__ __forceinline__ GAS unsigned char* launder_gptr(GAS unsigned char* q) { asm volatile("" : "+s"(q)); return q; }

__global__ void __launch_bounds__(NTHR, 2) fwd(Args args) {
    extern __shared__ __attribute__((aligned(16))) unsigned char lds_raw[];
    LAS unsigned char* const lds = (LAS unsigned char*)lds_raw;
    for (int u = threadIdx.x; u < (LDS_BYTES - LDSCTL_OFF) / 4; u += NTHR) ((LAS unsigned*)(lds + LDSCTL_OFF))[u] = 0u;
    __syncthreads();
    volatile LAS unsigned* MISC = (volatile LAS unsigned*)(lds + MISC_OFF);
    XcdBarrier bar; bar.bar = (unsigned*)(args.ws + WS_CTL) + CW_BAR; bar.x = 0; bar.st = nullptr;
    const bool fused = args.fused != 0;
    if (fused) bar = xcd_barrier_post((unsigned*)(args.ws + WS_CTL) + CW_BAR, MISC + 8);
#define GRID_BAR() do { if (fused) xcd_barrier(bar); } while (0)
    const int lo = args.ph_lo, hi = args.ph_hi;
#ifdef ONLY_PHASE
#define IN(k) (((ONLY_PHASE >> (k)) & 1) && lo <= (k) && (k) < hi)
#else
#define IN(k) (lo <= (k) && (k) < hi)
#endif
#ifndef PROBE_DUP
#define PROBE_DUP 0
#endif
#define REP(k) for (int rep_ = 0; rep_ < 1 + ((PROBE_DUP >> (k)) & 1); ++rep_)
#define PHASE_SETUP const Ctx C = make_ctx(lds); const P p = make_p(args, launder_gptr((GAS unsigned char*)args.ws))

    if (IN(PH_PRO)) REP(PH_PRO) { PHASE_SETUP; phase_prologue(C, p); GRID_BAR(); }
    if (IN(PH_MODFIN)) REP(PH_MODFIN) { PHASE_SETUP; phase_modfin(C, p); GRID_BAR(); }

    for (int l = args.l_lo; l < args.l_hi; ++l) {
        if (IN(PH_NORM1)) REP(PH_NORM1) { PHASE_SETUP; const float* modl = p.mod + (size_t)l * BATCH * NMOD;
            phase_norm_mod(C, p.X, p.g_mix + l * DM, modl + 0 * DM, modl + 1 * DM, p.XN); GRID_BAR(); }
        if (IN(PH_INPROJ)) REP(PH_INPROJ) { PHASE_SETUP;
            pg8::Gemm g{p.XN, p.win + (size_t)l * NZ * DM, M, NZ, DM}; pg8::StaticOrder S; S.init(M, NZ, C.G, C.bid, WGM_IN);
#if defined(PROBE_AMASK)
            const bool dummy_ = PROBE_DUP && rep_ == 0 && ((PROBE_DUP >> PH_INPROJ) & 1);
            if (dummy_) { g.amask = PROBE_AMASK; g.bmask = PROBE_BMASK; }
            pg8::EpiZ E{dummy_ ? (PROBE_BMASK == 12345 ? (bf16*)nullptr : p.H) : p.Z, p.rot};
            if (dummy_ && PROBE_BMASK == 12345) g.bmask = -1;
            if (dummy_ && PROBE_BMASK == 777) { g.bmask = -1; E.omask = ((size_t)1 << 24) - 8; }
            if (dummy_ && PROBE_BMASK == 778) { g.bmask = -1; E.omask = 0; }
#else
            pg8::EpiZ E{p.Z, p.rot};
#endif
            pg8::gemm_phase<pg8::EpiZ, pg8::StaticOrder, true, true, true, false, true>(C.lds, g, S, E);
            GRID_BAR();
        }
        if (IN(PH_MIXA)) REP(PH_MIXA) {
            REP(16) { PHASE_SETUP; asm volatile("; MARK_BEGIN phase_retA"); phase_retA(C, p); asm volatile("; MARK_END phase_retA"); }
            REP(17) { PHASE_SETUP; asm volatile("; MARK_BEGIN phase_glaA"); phase_glaA(C, p, l); asm volatile("; MARK_END phase_glaA"); }
            REP(18) { PHASE_SETUP; asm volatile("; MARK_BEGIN phase_pool"); phase_pool(C, p, l); asm volatile("; MARK_END phase_pool"); }
            GRID_BAR();
        }
        if (IN(PH_SCAN)) REP(PH_SCAN) { PHASE_SETUP; phase_scan(C, p); GRID_BAR(); }
        if (IN(PH_MIXB)) REP(PH_MIXB) {
            REP(19) { PHASE_SETUP; asm volatile("; MARK_BEGIN phase_retB"); phase_retB(C, p); asm volatile("; MARK_END phase_retB"); }
            REP(20) { PHASE_SETUP; asm volatile("; MARK_BEGIN phase_glaB"); phase_glaB(C, p, l); asm volatile("; MARK_END phase_glaB"); }
            GRID_BAR();
        }
        if (IN(PH_OUTPROJ)) REP(PH_OUTPROJ) { PHASE_SETUP; const float* modl = p.mod + (size_t)l * BATCH * NMOD;
            pg8::Gemm g{p.MIX, p.wout + (size_t)l * DM * DM, M, DM, DM}; pg8::StaticOrder S; S.init(M, DM, C.G, C.bid, WGM_OUT);
            pg8::EpiGateRes E{p.X, (PROBE_DUP && rep_ == 0 && ((PROBE_DUP >> PH_OUTPROJ) & 1)) ? p.Z : p.X, DM, modl + 2 * DM, NMOD, SEQ / 256};
            pg8::gemm_phase<pg8::EpiGateRes, pg8::StaticOrder, true, true, true, false, true>(C.lds, g, S, E);
            GRID_BAR();
        }
        if (IN(PH_NORM2)) REP(PH_NORM2) { PHASE_SETUP; const float* modl = p.mod + (size_t)l * BATCH * NMOD;
            phase_norm_mod(C, p.X, p.g_mlp + l * DM, modl + 3 * DM, modl + 4 * DM, p.XN); GRID_BAR(); }
        if (IN(PH_UP)) REP(PH_UP) { PHASE_SETUP;
            pg8::Gemm g{p.XN, p.wup + (size_t)l * DFF * DM, M, DFF, DM}; pg8::StaticOrder S; S.init(M, DFF, C.G, C.bid, WGM_UP);
            pg8::EpiRelu2 E{p.H, DFF};
            pg8::gemm_phase<pg8::EpiRelu2, pg8::StaticOrder, true, true, true, false, true>(C.lds, g, S, E);
            GRID_BAR();
        }
        if (IN(PH_DOWN)) REP(PH_DOWN) { PHASE_SETUP; const float* modl = p.mod + (size_t)l * BATCH * NMOD;
            pg8::Gemm g{p.H, p.wdn + (size_t)l * DM * DFF, M, DM, DFF}; pg8::StaticOrder S; S.init(M, DM, C.G, C.bid, WGM_DN); S.rev = true;
            pg8::EpiGateRes E{p.X, (PROBE_DUP && rep_ == 0 && ((PROBE_DUP >> PH_DOWN) & 1)) ? p.Z : p.X, DM, modl + 5 * DM, NMOD, SEQ / 256};
            pg8::gemm_phase<pg8::EpiGateRes, pg8::StaticOrder, true, true, true, true>(C.lds, g, S, E);
            GRID_BAR();
        }
    }
    if (IN(PH_FINAL)) { PHASE_SETUP; phase_norm_final(C, p.X, p.g_final, p.out); }
#undef IN
#undef GRID_BAR
#undef PHASE_SETUP
#undef REP
}

#ifndef N_LAUNCH_MODE
#define N_LAUNCH_MODE 1
#endif
extern "C" void kernel_launch(void* const* d_in, const int* in_sizes, int n_in, void* d_out, int out_size, void* d_ws, size_t ws_size, hipStream_t stream) {
    static int grid = 0;
    if (grid == 0) {
        if (n_in != 15 || in_sizes[0] != M * DM || out_size != M * DM || ws_size < WS_END) { fprintf(stderr, "kernel_launch: unexpected shapes (n_in %d, in0 %d, out %d, ws %zu < %zu)\n", n_in, n_in > 0 ? in_sizes[0] : -1, out_size, ws_size, (size_t)WS_END); grid = -1; return; }
        int dev = 0, cus = 0, per_cu = 0;
        if (hipGetDevice(&dev) != hipSuccess || hipDeviceGetAttribute(&cus, hipDeviceAttributeMultiprocessorCount, dev) != hipSuccess) { grid = -1; return; }
        if (hipFuncSetAttribute((const void*)fwd, hipFuncAttributeMaxDynamicSharedMemorySize, LDS_BYTES) != hipSuccess) { fprintf(stderr, "kernel_launch: hipFuncSetAttribute failed\n"); grid = -1; return; }
        if (hipOccupancyMaxActiveBlocksPerMultiprocessor(&per_cu, (const void*)fwd, NTHR, LDS_BYTES) != hipSuccess || per_cu < 1) fprintf(stderr, "kernel_launch: occupancy query reports %d\n", per_cu);
        (void)hipGetLastError();
        grid = cus;
    }
    if (grid < 0) return;
    (void)hipMemsetAsync((char*)d_ws + WS_CTL, 0, CTL_ZERO_BYTES, stream);
    Args a{};
    for (int i = 0; i < 15; ++i) a.in[i] = (const float*)d_in[i];
    a.out = (float*)d_out; a.ws = (unsigned char*)d_ws; a.pad = 0;
#if N_LAUNCH_MODE == 1
    a.l_lo = 0; a.l_hi = DEPTH; a.ph_lo = 0; a.ph_hi = PH_FINAL + 1; a.fused = 1;
    hipLaunchKernelGGL(fwd, dim3(grid), dim3(NTHR), LDS_BYTES, stream, a);
#else
    a.fused = 0;
    a.l_lo = 0; a.l_hi = 0;
    a.ph_lo = PH_PRO; a.ph_hi = PH_PRO + 1; hipLaunchKernelGGL(fwd, dim3(grid), dim3(NTHR), LDS_BYTES, stream, a);
    a.ph_lo = PH_MODFIN; a.ph_hi = PH_MODFIN + 1; hipLaunchKernelGGL(fwd, dim3(grid), dim3(NTHR), LDS_BYTES, stream, a);
    for (int l = 0; l < DEPTH; ++l) for (int ph = PH_NORM1; ph <= PH_DOWN; ++ph) {
        a.l_lo = l; a.l_hi = l + 1; a.ph_lo = ph; a.ph_hi = ph + 1;
        hipLaunchKernelGGL(fwd, dim3(grid), dim3(NTHR), LDS_BYTES, stream, a);
    }
    a.l_lo = 0; a.l_hi = 0; a.ph_lo = PH_FINAL; a.ph_hi = PH_FINAL + 1;
    hipLaunchKernelGGL(fwd, dim3(grid), dim3(NTHR), LDS_BYTES, stream, a);
#endif
    const hipError_t le = hipPeekAtLastError();
    if (le != hipSuccess) fprintf(stderr, "kernel_launch: launch failed: %s\n", hipGetErrorName(le));
}
```

```cpp
#include <hip/hip_runtime.h>
#include <cstdio>
#include <cstdint>
namespace pg8 {
#define PG8_LAS __attribute__((address_space(3)))
typedef unsigned short bf16_t;
typedef short bf16x8 __attribute__((ext_vector_type(8)));
typedef float f32x4 __attribute__((ext_vector_type(4)));
typedef unsigned u32x4 __attribute__((ext_vector_type(4)));
constexpr int BM = 256, BK = 64, HALF = 128, HTB = HALF * BK * 2  , STAGE_BYTES = 8 * HTB, NXCD = 8, WGM = 8;

__host__ __device__ __forceinline__ int lds_byte(int r, int c) { const int st = (r >> 4) * 2 + (c >> 5), rr = r & 15, cc = c & 31, ob = rr * 64 + cc * 2; return st * 1024 + (ob ^ (((ob >> 9) & 1) << 5)); }
__host__ __device__ __forceinline__ void stage_rc(int b, int& R, int& C) { const int st = b / 1024, sb = b % 1024, swz = sb ^ (((sb >> 9) & 1) << 5); R = (st >> 1) * 16 + swz / 64; C = (st & 1) * 32 + (swz % 64) / 2; }
__host__ __device__ __forceinline__ int perm32(int rho) { const int n = rho >> 4, i = rho & 15; return 8 * (i >> 2) + 4 * n + (i & 3); }

__host__ __device__ __forceinline__ size_t tiled_off(int row, int col, int K) { return ((size_t)(row >> 8) * (K >> 6) + (col >> 6)) * (BM * BK) + (size_t)((row & 255) * BK + (col & 63)); }
__host__ __device__ __forceinline__ size_t subtiled_off(int row, int col, int K) { const int r = row & 255, c = col & 63; return ((size_t)(row >> 8) * (K >> 6) + (col >> 6)) * (BM * BK) + (size_t)((((r >> 4) * 2 + (c >> 5)) << 9) + (r & 15) * 32 + (c & 31)); }
__host__ __device__ __forceinline__ size_t xblk_off(int row, int col, int ncols) { return ((size_t)(row >> 4) * (ncols >> 5) + (col >> 5)) * 512 + (size_t)((row & 15) * 32 + (col & 31)); }
struct Unit { int pm, pn; };
struct Gemm { const bf16_t* A; const bf16_t* Bt; int M, N, K; int amask = -1, bmask = -1; };

struct StaticOrder {
    int nM, nN, nwg, G, c, wgm;
    __host__ __device__ void init(int M, int N, int G_, int c_, int wgm_ = WGM) { nM = M / BM; nN = N / BM; nwg = nM * nN; G = G_; c = c_; wgm = wgm_; }
    __host__ __device__ bool next(int i, Unit& u) const {
        const long L = (long)i * G + c; if (L >= nwg) return false;
        int wgid = (int)L; { const int q = nwg / NXCD, r = nwg % NXCD, xcd = wgid % NXCD, off = wgid / NXCD; wgid = (xcd < r ? xcd * (q + 1) : r * (q + 1) + (xcd - r) * q) + off; }
        const int nig = wgm * nN, gid = wgid / nig, fm = gid * wgm, gsz = (nM - fm) < wgm ? (nM - fm) : wgm;
        u.pm = fm + ((wgid % nig) % gsz); u.pn = (wgid % nig) / gsz; return true;
    }
    __device__ __forceinline__ void a_ready(const Unit&) const {}
    __device__ __forceinline__ void done(const Unit&) const {}
};

__device__ __forceinline__ unsigned cvt_pk_bf16(float lo, float hi) { unsigned r; asm volatile("v_cvt_pk_bf16_f32 %0, %1, %2" : "=v"(r) : "v"(lo), "v"(hi)); return r; }
typedef float f32x2 __attribute__((ext_vector_type(2)));
__device__ __forceinline__ f32x2 gelu_pk(f32x2 v) {
    const f32x2 av = __builtin_elementwise_abs(v), d = av * 0.2316418882f + 1.0f;
    f32x2 t; t.x = __builtin_amdgcn_rcpf(d.x); t.y = __builtin_amdgcn_rcpf(d.y);
    f32x2 q = t * 0.5307027145f + (-0.7265760135f); q = q * t + 0.7107068705f; q = q * t + (-0.142248368f); q = q * t + 0.127414796f; q = q * t;
    const f32x2 s = (v * v) * (-0.72134752044f);
    f32x2 e; e.x = __builtin_amdgcn_exp2f(s.x); e.y = __builtin_amdgcn_exp2f(s.y);
    const f32x2 m = v * (q * e), r = v - m;
    f32x2 o; o.x = v.x < 0.f ? m.x : r.x; o.y = v.y < 0.f ? m.y : r.y; return o;
}

template <int ACT  > struct EpiBf16 {
    static constexpr bool PERM = true, AFTER_DRAIN = false; static_assert(ACT == 0 || ACT == 1, "EpiBf16: ACT is 0 (none) or 1 (gelu_pk)");
    bf16_t* O; int ldc; const float* bias; int split_cols; size_t split_stride; float scale0;
    __device__ __forceinline__ void operator()(const f32x4 (&acc)[2][2][4][2], const Unit& u, int wr, int wc, int fr, int fq) const {
        const int row0 = u.pm * BM + wr * 64 + fr; int colt = u.pn * BM; bf16_t* base = O;
        float sc = 1.f; if (split_cols) { const int t = colt / split_cols; base += (size_t)t * split_stride; colt -= t * split_cols; if (t == 0) sc = scale0; }
        const int col0 = colt + wc * 32 + 8 * fq, bcol0 = u.pn * BM + wc * 32 + 8 * fq;
        f32x4 bv[2][2];
#pragma unroll
        for (int bj = 0; bj < 2; ++bj)
#pragma unroll
            for (int n = 0; n < 2; ++n) bv[bj][n] = bias ? *(const f32x4*)(bias + bcol0 + bj * HALF + 4 * n) : (f32x4){0.f, 0.f, 0.f, 0.f};
#pragma unroll
        for (int ai = 0; ai < 2; ++ai)
#pragma unroll
            for (int m = 0; m < 4; ++m) { bf16_t* rowp = base + (size_t)(row0 + ai * HALF + m * 16) * ldc + col0;
#pragma unroll
                for (int bj = 0; bj < 2; ++bj) { f32x4 v0 = acc[ai][bj][m][0] + bv[bj][0], v1 = acc[ai][bj][m][1] + bv[bj][1];
                    if (ACT == 1) { f32x2 a = gelu_pk((f32x2){v0[0], v0[1]}), b = gelu_pk((f32x2){v0[2], v0[3]}), c = gelu_pk((f32x2){v1[0], v1[1]}), d = gelu_pk((f32x2){v1[2], v1[3]});
                        v0 = (f32x4){a.x, a.y, b.x, b.y}; v1 = (f32x4){c.x, c.y, d.x, d.y}; }
                    v0 = v0 * sc; v1 = v1 * sc; u32x4 w; w.x = cvt_pk_bf16(v0[0], v0[1]); w.y = cvt_pk_bf16(v0[2], v0[3]); w.z = cvt_pk_bf16(v1[0], v1[1]); w.w = cvt_pk_bf16(v1[2], v1[3]);
                    *(u32x4*)(rowp + bj * HALF) = w; } }
    }
};

struct EpiRelu2 {
    static constexpr bool PERM = true, AFTER_DRAIN = false;
    bf16_t* O; int ldc;
    __device__ __forceinline__ void operator()(const f32x4 (&acc)[2][2][4][2], const Unit& u, int wr, int wc, int fr, int fq) const {
        const int row0 = u.pm * BM + wr * 64 + fr; const int col0 = u.pn * BM + wc * 32 + 8 * fq;
#pragma unroll
        for (int ai = 0; ai < 2; ++ai)
#pragma unroll
            for (int m = 0; m < 4; ++m) { const int row = row0 + ai * HALF + m * 16;
#pragma unroll
                for (int bj = 0; bj < 2; ++bj) { f32x4 v0 = acc[ai][bj][m][0], v1 = acc[ai][bj][m][1];
                    v0 = __builtin_elementwise_max(v0, (f32x4){0.f, 0.f, 0.f, 0.f}); v1 = __builtin_elementwise_max(v1, (f32x4){0.f, 0.f, 0.f, 0.f});
                    v0 = v0 * v0; v1 = v1 * v1;
                    u32x4 w; w.x = cvt_pk_bf16(v0[0], v0[1]); w.y = cvt_pk_bf16(v0[2], v0[3]); w.z = cvt_pk_bf16(v1[0], v1[1]); w.w = cvt_pk_bf16(v1[2], v1[3]);
                    *(u32x4*)(O + subtiled_off(row, col0 + bj * HALF, ldc)) = w; } }
    }
};
typedef _Float16 h16x2 __attribute__((ext_vector_type(2)));
__device__ __forceinline__ unsigned res_pk(float lo, float hi) { const h16x2 h = {(_Float16)lo, (_Float16)hi}; return __builtin_bit_cast(unsigned, h); }
__device__ __forceinline__ float res_lo(unsigned w) { return (float)__builtin_bit_cast(h16x2, w).x; }
__device__ __forceinline__ float res_hi(unsigned w) { return (float)__builtin_bit_cast(h16x2, w).y; }
struct EpiGateRes {
    static constexpr bool PERM = true, AFTER_DRAIN = false;
    const bf16_t* base; bf16_t* out; int ldc; const float* gate; int gate_stride; int panels_per_batch;
    __device__ __forceinline__ void operator()(const f32x4 (&acc)[2][2][4][2], const Unit& u, int wr, int wc, int fr, int fq) const {
        const int row0 = u.pm * BM + wr * 64 + fr; const int col0 = u.pn * BM + wc * 32 + 8 * fq;
        const float* gp = gate + (size_t)(u.pm / panels_per_batch) * gate_stride + col0;
        f32x4 gv[2][2];
#pragma unroll
        for (int bj = 0; bj < 2; ++bj)
#pragma unroll
            for (int n = 0; n < 2; ++n) gv[bj][n] = *(const f32x4*)(gp + bj * HALF + 4 * n);
#pragma unroll
        for (int ai = 0; ai < 2; ++ai) {
            u32x4 bsv[4][2];
#pragma unroll
            for (int m = 0; m < 4; ++m)
#pragma unroll
                for (int bj = 0; bj < 2; ++bj) bsv[m][bj] = *(const u32x4*)(base + xblk_off(row0 + ai * HALF + m * 16, col0 + bj * HALF, ldc));
#pragma unroll
            for (int m = 0; m < 4; ++m) {
#pragma unroll
                for (int bj = 0; bj < 2; ++bj) { const u32x4 bs = bsv[m][bj];
                    const f32x4 v0 = gv[bj][0] * acc[ai][bj][m][0], v1 = gv[bj][1] * acc[ai][bj][m][1];
                    u32x4 w;
                    w.x = res_pk(res_lo(bs.x) + v0[0], res_hi(bs.x) + v0[1]);
                    w.y = res_pk(res_lo(bs.y) + v0[2], res_hi(bs.y) + v0[3]);
                    w.z = res_pk(res_lo(bs.z) + v1[0], res_hi(bs.z) + v1[1]);
                    w.w = res_pk(res_lo(bs.w) + v1[2], res_hi(bs.w) + v1[3]);
                    *(u32x4*)(out + xblk_off(row0 + ai * HALF + m * 16, col0 + bj * HALF, ldc)) = w; } }
            asm volatile("" ::: "memory");
        }
    }
};

constexpr int ZSEQ = 4096;
constexpr int ZO_Q = 0, ZO_K = 12582912, ZO_V = 25165824, ZO_G = 37748736, ZO_P = 50331648, ZO_GQ = 58720256, ZO_GK = 65011712, ZO_GV = 71303168, ZO_GR = 83886080, ZO_GZ = 96468992;
__device__ __forceinline__ int zmap(int cg, int bq, int& grp, int& rs) {
    const bool r1 = cg < 3072, r2 = cg < 3584, r3 = cg < 4352, r4 = cg < 5888, r5 = cg < 5904;
    const int csA = r1 ? cg : cg - 3072;
    const int secA = r1 ? cg / 768 : 0, inA = r1 ? cg % 768 : csA, cA = inA & 127;
    const int offA = (r1 ? secA * ZO_K : ZO_P) + ((bq * (r1 ? 6 : 4) + (inA >> 7)) * ZSEQ) * 128 + (cA >> 5) * 512 + (cA & 31);
    const int csB = cg - 3584, s2B = csB / 384, rB = csB % 384, cB = rB % 96;
    const int offB = ZO_GQ + s2B * (ZO_GK - ZO_GQ) + ((bq * 4 + rB / 96) * ZSEQ) * 96 + (cB >> 5) * 512 + (cB & 31);
    const int csC = cg - 4352, s2C = csC / 768, rC = csC % 768, cC = rC % 192;
    const int offC = ZO_GV + s2C * (ZO_GR - ZO_GV) + ((bq * 4 + rC / 192) * ZSEQ) * 192 + (cC >> 5) * 512 + (cC & 31);
    const int offD = ZO_GZ + bq * ZSEQ * 16 + (cg - 5888);
    grp = r2 ? 16 * 128 : (r3 ? 16 * 96 : (r4 ? 16 * 192 : (r5 ? 256 : 0)));
    rs = r4 ? 32 : 16;
    return r2 ? offA : (r3 ? offB : (r4 ? offC : offD));
}
struct EpiZ {
    static constexpr bool PERM = true, AFTER_DRAIN = false;
    bf16_t* O; const unsigned* rot;
#if defined(PROBE_AMASK)
    size_t omask = ~(size_t)0;
#endif
    __device__ __forceinline__ void operator()(const f32x4 (&acc)[2][2][4][2], const Unit& u, int wr, int wc, int fr, int fq) const {
#if defined(PROBE_AMASK)
        if (!O) return;
#endif
        const int row0 = u.pm * BM + wr * 64 + fr; const int col0 = u.pn * BM + wc * 32 + 8 * fq;
        const int mode = (u.pn < 6) ? 1 : (((u.pn >= 9 && u.pn < 12) || (u.pn >= 20 && u.pn < 23)) ? 2 : 0);
        const int i0 = wc * 16 + 4 * fq;
        const int bq = (u.pm * BM) / ZSEQ;
        int off[2], grp[2], rs[2];
#pragma unroll
        for (int bj = 0; bj < 2; ++bj) off[bj] = zmap(col0 + bj * HALF, bq, grp[bj], rs[bj]);
        u32x4 rotv[2][4];
        if (mode == 1) {
#pragma unroll
            for (int ai = 0; ai < 2; ++ai)
#pragma unroll
                for (int m = 0; m < 4; ++m) rotv[ai][m] = *(const u32x4*)(rot + (size_t)((row0 + ai * HALF + m * 16) & (ZSEQ - 1)) * 64 + i0);
        }
#pragma unroll
        for (int ai = 0; ai < 2; ++ai) {
#pragma unroll
            for (int m = 0; m < 4; ++m) { const int row = row0 + ai * HALF + m * 16; const int t = row & (ZSEQ - 1);
                f32x4 cs = {1.f, 1.f, 1.f, 1.f}, sn = {0.f, 0.f, 0.f, 0.f};
                if (mode == 1) { const u32x4 q = rotv[ai][m]; cs = (f32x4){res_lo(q.x), res_lo(q.y), res_lo(q.z), res_lo(q.w)}; sn = (f32x4){res_hi(q.x), res_hi(q.y), res_hi(q.z), res_hi(q.w)}; }
#pragma unroll
                for (int bj = 0; bj < 2; ++bj) { f32x4 v0 = acc[ai][bj][m][0], v1 = acc[ai][bj][m][1];
                    if (mode == 1) {
                        const f32x4 a0 = v0, a1 = v1;
                        v0[0] = a0[0] * cs[0] - a0[1] * sn[0]; v0[1] = a0[0] * sn[0] + a0[1] * cs[0];
                        v0[2] = a0[2] * cs[1] - a0[3] * sn[1]; v0[3] = a0[2] * sn[1] + a0[3] * cs[1];
                        v1[0] = a1[0] * cs[2] - a1[1] * sn[2]; v1[1] = a1[0] * sn[2] + a1[1] * cs[2];
                        v1[2] = a1[2] * cs[3] - a1[3] * sn[3]; v1[3] = a1[2] * sn[3] + a1[3] * cs[3];
                    } else if (mode == 2) {
#pragma unroll
                        for (int e = 0; e < 4; ++e) { v0[e] = v0[e] * __builtin_amdgcn_rcpf(1.f + __expf(-v0[e])); v1[e] = v1[e] * __builtin_amdgcn_rcpf(1.f + __expf(-v1[e])); }
                    }
                    u32x4 wv; wv.x = cvt_pk_bf16(v0[0], v0[1]); wv.y = cvt_pk_bf16(v0[2], v0[3]); wv.z = cvt_pk_bf16(v1[0], v1[1]); wv.w = cvt_pk_bf16(v1[2], v1[3]);
#if defined(PROBE_AMASK)
                    if (grp[bj] != 0 && (omask != 0 || wv.x == 0x12345678u)) *(u32x4*)(O + ((size_t)(unsigned)(off[bj] + (t >> 4) * grp[bj] + (t & 15) * rs[bj]) & omask)) = wv; } }
#else
                    if (grp[bj] != 0) *(u32x4*)(O + (size_t)(unsigned)(off[bj] + (t >> 4) * grp[bj] + (t & 15) * rs[bj])) = wv; } }
#endif
        }
    }
};

template <class Epi, class Sched, bool ALIGN_EPI = false, bool SP2 = false, bool TILED = true, bool ASUB = false, bool AROWMAJOR = false>
__device__ __forceinline__ void gemm_phase(PG8_LAS unsigned char* lds, const Gemm g, const Sched& S, const Epi& E) {
    int tid_ = threadIdx.x; asm volatile("" : "+v"(tid_));
    const int tid = tid_, wid = __builtin_amdgcn_readfirstlane(tid >> 6), lane = tid & 63, wr = wid >> 2, wc = wid & 3, fr = lane & 15, fq = lane >> 4;
    const int K = g.K, nt = K / BK;
    unsigned voffA[2], voffB[2];
#pragma unroll
    for (int i = 0; i < 2; ++i) { int R, C; stage_rc(tid * 16 + i * 8192, R, C); const int Rb = Epi::PERM ? ((R & ~31) + perm32(R & 31)) : R;
        voffA[i] = ASUB ? (unsigned)((((R >> 4) * 2 + (C >> 5)) << 9) + (R & 15) * 32 + (C & 31)) * 2u : (unsigned)(R * ((TILED && !AROWMAJOR) ? BK : K) + C) * 2u; voffB[i] = (unsigned)(Rb * (TILED ? BK : K) + C) * 2u; }
    const size_t kstep = TILED ? (size_t)(BM * BK * 2) : (size_t)(BK * 2);
    const size_t hstep = TILED ? (size_t)(HALF * BK * 2) : (size_t)HALF * K * 2;
    const size_t tstep = TILED ? (size_t)nt * (BM * BK * 2) : 2 * (size_t)HALF * K * 2;
    const size_t kstepA = (TILED && !AROWMAJOR) ? kstep : (size_t)(BK * 2), hstepA = (TILED && !AROWMAJOR) ? hstep : (size_t)HALF * K * 2, tstepA = (TILED && !AROWMAJOR) ? tstep : 2 * (size_t)HALF * K * 2;
    const unsigned ldsw = (unsigned)wid * 1024u;
    const int aoff = lds_byte(wr * 64 + fr, fq * 8), boff = lds_byte(wc * 32 + fr, fq * 8);
#define PG8_SA(b, h) (((b) * 2 + (h)) * HTB)
#define PG8_SB(b, h) ((4 + (b) * 2 + (h)) * HTB)
#define PG8_STAGE(bufoff, gbase, voff) do { _Pragma("unroll") for (int _i = 0; _i < 2; ++_i) \
        __builtin_amdgcn_global_load_lds((const unsigned*)((const char*)(gbase) + (voff)[_i]), (PG8_LAS unsigned*)(lds + (bufoff) + ldsw + _i * 8192), 16, 0, 0); } while (0)
#define PG8_LDA(dst, b, h) do { _Pragma("unroll") for (int m = 0; m < 4; ++m) _Pragma("unroll") for (int k = 0; k < 2; ++k) dst[m][k] = *(const PG8_LAS bf16x8*)(lds + PG8_SA(b, h) + aoff + m * 2048 + k * 1024); } while (0)
#define PG8_LDB(dst, b, h) do { _Pragma("unroll") for (int n = 0; n < 2; ++n) _Pragma("unroll") for (int k = 0; k < 2; ++k) dst[n][k] = *(const PG8_LAS bf16x8*)(lds + PG8_SB(b, h) + boff + n * 2048 + k * 1024); } while (0)
#define PG8_MMA(ai, bj, At, Bt) do { __builtin_amdgcn_s_setprio(1); _Pragma("unroll") for (int m = 0; m < 4; ++m) _Pragma("unroll") for (int n = 0; n < 2; ++n) _Pragma("unroll") for (int k = 0; k < 2; ++k) \
        acc[ai][bj][m][n] = __builtin_amdgcn_mfma_f32_16x16x32_bf16(Bt[n][k], At[m][k], acc[ai][bj][m][n], 0, 0, 0); __builtin_amdgcn_s_setprio(0); } while (0)
#define PG8_WAIT_V(n) asm volatile("s_waitcnt vmcnt(" #n ")" ::: "memory")
#define PG8_WAIT_L(n) asm volatile("s_waitcnt lgkmcnt(" #n ")" ::: "memory")
#define PG8_BAR __builtin_amdgcn_s_barrier()
#define PG8_SCHED __builtin_amdgcn_sched_barrier(0)
    Unit cur, nxt; int ui = 0;
    if (!S.next(0, cur)) return;
    f32x4 acc[2][2][4][2];
#pragma unroll
    for (int a = 0; a < 2; ++a)
#pragma unroll
        for (int b = 0; b < 2; ++b)
#pragma unroll
            for (int m = 0; m < 4; ++m)
#pragma unroll
                for (int n = 0; n < 2; ++n) acc[a][b][m][n] = (f32x4){0.f, 0.f, 0.f, 0.f};
    bf16x8 At[4][2], B0[2][2], B1[2][2];
    const char* cA = (const char*)g.A + (size_t)(cur.pm & g.amask) * tstepA; const char* cB = (const char*)g.Bt + (size_t)(cur.pn & g.bmask) * tstep;
    S.a_ready(cur);
    if constexpr (SP2) {
        PG8_STAGE(PG8_SB(0, 0), cB, voffB); PG8_STAGE(PG8_SB(0, 1), cB + hstep, voffB); PG8_STAGE(PG8_SA(0, 0), cA, voffA); PG8_STAGE(PG8_SA(0, 1), cA + hstepA, voffA);
        if (wr == 1) PG8_BAR;
        PG8_WAIT_V(2); PG8_BAR;
        PG8_STAGE(PG8_SB(1, 0), cB + kstep, voffB); PG8_STAGE(PG8_SA(1, 0), cA + kstepA, voffA); PG8_STAGE(PG8_SB(1, 1), cB + hstep + kstep, voffB);
        PG8_WAIT_V(6); PG8_BAR;
    } else {
        PG8_STAGE(PG8_SB(0, 0), cB, voffB); PG8_STAGE(PG8_SA(0, 0), cA, voffA); PG8_STAGE(PG8_SB(0, 1), cB + hstep, voffB); PG8_STAGE(PG8_SA(0, 1), cA + hstepA, voffA);
        if (wr == 1) PG8_BAR;
        PG8_WAIT_V(4); PG8_BAR;
        PG8_STAGE(PG8_SB(1, 0), cB + kstep, voffB); PG8_STAGE(PG8_SA(1, 0), cA + kstepA, voffA); PG8_STAGE(PG8_SB(1, 1), cB + hstep + kstep, voffB);
        PG8_WAIT_V(6); PG8_BAR;
    }
    for (;;) {
        const bool has_next = S.next(ui + 1, nxt);
        const char* nA = has_next ? (const char*)g.A + (size_t)(nxt.pm & g.amask) * tstepA : cA; const char* nB = has_next ? (const char*)g.Bt + (size_t)(nxt.pn & g.bmask) * tstep : cB;
        for (int t = 0; t < nt; t += 2) {
            const bool last = (t == nt - 2);
            const char* a1 = cA + (size_t)(t + 1) * kstepA;
            const char* a2 = last ? nA : cA + (size_t)(t + 2) * kstepA; const char* b2 = last ? nB : cB + (size_t)(t + 2) * kstep;
            const char* a3 = a2 + kstepA; const char* b3 = b2 + kstep;
            if (last && has_next) S.a_ready(nxt);
            if constexpr (SP2) {
            PG8_LDB(B0, 0, 0); PG8_LDB(B1, 0, 1); PG8_SCHED; PG8_LDA(At, 0, 0); PG8_STAGE(PG8_SA(1, 1), a1 + hstepA, voffA);
            PG8_WAIT_V(8); PG8_WAIT_L(0); PG8_BAR; PG8_MMA(0, 0, At, B0); PG8_MMA(0, 1, At, B1); PG8_BAR; PG8_SCHED;
            PG8_LDA(At, 0, 1); PG8_STAGE(PG8_SB(0, 0), b2, voffB); PG8_STAGE(PG8_SB(0, 1), b2 + hstep, voffB); PG8_STAGE(PG8_SA(0, 0), a2, voffA);
            PG8_WAIT_V(8); PG8_WAIT_L(0); PG8_BAR; PG8_MMA(1, 0, At, B0); PG8_MMA(1, 1, At, B1); PG8_BAR; PG8_SCHED;
            PG8_LDB(B0, 1, 0); PG8_LDB(B1, 1, 1); PG8_SCHED; PG8_LDA(At, 1, 0); PG8_STAGE(PG8_SA(0, 1), a2 + hstepA, voffA);
            PG8_WAIT_V(8); PG8_WAIT_L(0); PG8_BAR; PG8_MMA(0, 0, At, B0); PG8_MMA(0, 1, At, B1); PG8_BAR; PG8_SCHED;
            PG8_LDA(At, 1, 1); PG8_STAGE(PG8_SB(1, 0), b3, voffB); PG8_STAGE(PG8_SB(1, 1), b3 + hstep, voffB); PG8_STAGE(PG8_SA(1, 0), a3, voffA);
            PG8_WAIT_V(8); PG8_WAIT_L(0); PG8_BAR; PG8_MMA(1, 0, At, B0); PG8_MMA(1, 1, At, B1); PG8_BAR; PG8_SCHED;
            } else {
            PG8_LDB(B0, 0, 0); PG8_SCHED; PG8_LDA(At, 0, 0); PG8_STAGE(PG8_SA(1, 1), a1 + hstepA, voffA);
            PG8_WAIT_L(8); PG8_BAR; PG8_WAIT_L(0); PG8_MMA(0, 0, At, B0); PG8_BAR; PG8_SCHED;
            PG8_LDB(B1, 0, 1); PG8_STAGE(PG8_SB(0, 0), b2, voffB);
            PG8_BAR; PG8_WAIT_L(0); PG8_MMA(0, 1, At, B1); PG8_BAR;
            PG8_LDA(At, 0, 1); PG8_STAGE(PG8_SA(0, 0), a2, voffA);
            PG8_BAR; PG8_WAIT_L(0); PG8_MMA(1, 0, At, B0); PG8_BAR; PG8_SCHED;
            PG8_STAGE(PG8_SB(0, 1), b2 + hstep, voffB);
            PG8_WAIT_V(6); PG8_BAR; PG8_MMA(1, 1, At, B1); PG8_BAR;
            PG8_LDB(B0, 1, 0); PG8_SCHED; PG8_LDA(At, 1, 0); PG8_STAGE(PG8_SA(0, 1), a2 + hstepA, voffA);
            PG8_WAIT_L(8); PG8_BAR; PG8_WAIT_L(0); PG8_MMA(0, 0, At, B0); PG8_BAR; PG8_SCHED;
            PG8_LDB(B1, 1, 1); PG8_STAGE(PG8_SB(1, 0), b3, voffB);
            PG8_BAR; PG8_WAIT_L(0); PG8_MMA(0, 1, At, B1); PG8_BAR;
            PG8_LDA(At, 1, 1); PG8_STAGE(PG8_SA(1, 0), a3, voffA);
            PG8_BAR; PG8_WAIT_L(0); PG8_MMA(1, 0, At, B0); PG8_BAR; PG8_SCHED;
            PG8_STAGE(PG8_SB(1, 1), b3 + hstep, voffB);
            PG8_WAIT_V(6); PG8_BAR; PG8_MMA(1, 1, At, B1); PG8_BAR;
            }
        }
        if constexpr (ALIGN_EPI) { if (wr == 0) PG8_BAR; }
        if constexpr (!Epi::AFTER_DRAIN) { E(acc, cur, wr, wc, fr, fq); S.done(cur); }
        if (!has_next) break;
#pragma unroll
        for (int a = 0; a < 2; ++a)
#pragma unroll
            for (int b = 0; b < 2; ++b)
#pragma unroll
                for (int m = 0; m < 4; ++m)
#pragma unroll
                    for (int n = 0; n < 2; ++n) acc[a][b][m][n] = (f32x4){0.f, 0.f, 0.f, 0.f};
        cur = nxt; cA = nA; cB = nB; ++ui;
        if constexpr (ALIGN_EPI) { if (wr == 1) PG8_BAR; }
    }
    PG8_WAIT_V(0);
    if constexpr (!ALIGN_EPI) { if (wr == 0) PG8_BAR; }
    PG8_BAR;
    if constexpr (Epi::AFTER_DRAIN) { E.fused(acc, cur, wr, wc, fr, fq, lds, wid, lane); S.done(cur); }
#undef PG8_SA
#undef PG8_SB
#undef PG8_STAGE
#undef PG8_LDA
#undef PG8_LDB
#undef PG8_MMA
#undef PG8_WAIT_V
#undef PG8_WAIT_L
#undef PG8_BAR
#undef PG8_SCHED
}
}

constexpr int NWAVES = 8, NTHR = NWAVES * 64;
constexpr int BATCH = 4, SEQ = 4096, DM = 2048, DEPTH = 4, DFF = 8192;
constexpr int M = BATCH * SEQ;
constexpr int NIN = 5904, NZ = 6144;
using pg8::ZO_Q; using pg8::ZO_K; using pg8::ZO_V; using pg8::ZO_G; using pg8::ZO_P; using pg8::ZO_GQ; using pg8::ZO_GK; using pg8::ZO_GV; using pg8::ZO_GR; using pg8::ZO_GZ;
constexpr int MIX_RET = 0, MIX_POOL = 768, MIX_GLA = 1280;
constexpr int RH = 6, RD = 128, RC = 128, RNC = SEQ / RC;
constexpr int GH = 4, GDK = 96, GDV = 192, GC = 64, GNC = SEQ / GC;
constexpr int NMOD = 6 * DM;
constexpr float EPS = 1e-6f;
constexpr int KS_ADA = 32;

constexpr size_t MiB = 1u << 20;
constexpr size_t WS_CTL = 0, CTL_ZERO_BYTES = 32768;
constexpr size_t WS_MOD = 1 * MiB;
constexpr size_t WS_MODP = 848 * MiB;
constexpr size_t WS_COS = 10 * MiB;
constexpr size_t WS_GCH = 12 * MiB;
constexpr size_t WS_WIN = 16 * MiB;
constexpr size_t WS_WOUT = 112 * MiB;
constexpr size_t WS_WUP = 144 * MiB;
constexpr size_t WS_WDN = 272 * MiB;
constexpr size_t WS_X = 400 * MiB;
constexpr size_t WS_XN = 528 * MiB;
constexpr size_t WS_Z = 592 * MiB;
constexpr size_t WS_MIX = 784 * MiB;
constexpr size_t WS_H = 848 * MiB;
constexpr size_t WS_URET = 1104 * MiB;
constexpr size_t WS_RPREV = 1152 * MiB;
constexpr size_t WS_UGLA = 1176 * MiB;
constexpr size_t WS_SPREV = 1248 * MiB;
constexpr size_t WS_GB = 1284 * MiB;
constexpr size_t WS_END = 1308 * MiB;
constexpr int CW_BAR = 4096;

constexpr int RING_BYTES = 143360;
constexpr int LDSCTL_OFF = RING_BYTES, MISC_OFF = LDSCTL_OFF + 320;
constexpr int LDS_BYTES = 147456;

#define GAS __attribute__((address_space(1)))
#define LAS __attribute__((address_space(3)))
typedef unsigned short bf16;
typedef unsigned v4u __attribute__((ext_vector_type(4)));
typedef unsigned v2u __attribute__((ext_vector_type(2)));
typedef float f32x4 __attribute__((ext_vector_type(4)));
typedef short bf16x8 __attribute__((ext_vector_type(8)));
typedef short s16x4 __attribute__((ext_vector_type(4)));
typedef GAS unsigned gu32;
#define RLX_AGENT __ATOMIC_RELAXED, __HIP_MEMORY_SCOPE_AGENT

__device__ __forceinline__ unsigned f2bf(float f) { unsigned u = __builtin_bit_cast(unsigned, f); return (u + 0x7fffu + ((u >> 16) & 1u)) >> 16; }
typedef float f32x2_t __attribute__((ext_vector_type(2)));
typedef __bf16 bf16x2_t __attribute__((ext_vector_type(2)));
__device__ __forceinline__ unsigned pk2(float lo, float hi) { const f32x2_t v = {lo, hi}; return __builtin_bit_cast(unsigned, __builtin_convertvector(v, bf16x2_t)); }
__device__ __forceinline__ float bf2f(unsigned h) { return __builtin_bit_cast(float, h << 16); }
__device__ __forceinline__ float bflo(unsigned w) { return __builtin_bit_cast(float, w << 16); }
__device__ __forceinline__ float bfhi(unsigned w) { return __builtin_bit_cast(float, w & 0xffff0000u); }

#define XB_TMO      128
#define XB_XCNT(j)  (256  + 64 * (j))
#define XB_XSUB(j)  (1280 + 64 * (j))
#define XB_XGEN(j)  (2304 + 64 * (j))
#define XB_TOP      3328
#define XB_TOPGEN   3392
#define XCD_BAR_WORDS 3456
#define XB_SPIN_CAP (1u << 18)

__device__ __forceinline__ unsigned xb_ld(unsigned* p)              { return __hip_atomic_load(p, __ATOMIC_RELAXED, __HIP_MEMORY_SCOPE_AGENT); }
__device__ __forceinline__ unsigned xb_add(unsigned* p, unsigned v) { return __hip_atomic_fetch_add(p, v, __ATOMIC_RELAXED, __HIP_MEMORY_SCOPE_AGENT); }
__device__ __forceinline__ unsigned xb_xcc_id() { return (unsigned)__builtin_amdgcn_s_getreg((3 << 11) | 20) & 0xFu; }
#define XB_SPIN(cond, bar) do { unsigned _sp = 0; while (cond) { __builtin_amdgcn_s_sleep(1); \
    if ((++_sp & 255u) == 0u) { if (xb_ld(&(bar)[XB_TMO])) break; if (_sp > XB_SPIN_CAP) { atomicAdd(&(bar)[XB_TMO], 1u); break; } } } } while (0)

struct XcdBarrier {
    unsigned* bar; unsigned x;
    volatile LAS unsigned* st;
};

__device__ __forceinline__ XcdBarrier xcd_barrier_post(unsigned* bar, volatile LAS unsigned* st) {
    XcdBarrier b; b.bar = bar; b.x = xb_xcc_id(); b.st = st;
    if (threadIdx.x == 0) (void)xb_add(&bar[XB_XCNT(b.x)], 1u);
    return b;
}
__device__ __forceinline__ void xcd_barrier_complete(unsigned* bar, unsigned x, unsigned& nloc, unsigned& nx) {
    const unsigned G = gridDim.x * gridDim.y * gridDim.z;
    unsigned sum, cnt, mine, sp = 0u;
    for (;;) {
        sum = 0u; cnt = 0u; mine = 0u;
#pragma unroll
        for (unsigned j = 0; j < 16; ++j) { const unsigned c = xb_ld(&bar[XB_XCNT(j)]); sum += c; cnt += (c > 0u) ? 1u : 0u; mine = (j == x) ? c : mine; }
        if (sum == G) break;
        __builtin_amdgcn_s_sleep(1);
        if ((++sp & 255u) == 0u) { if (xb_ld(&bar[XB_TMO])) break; if (sp > XB_SPIN_CAP) { atomicAdd(&bar[XB_TMO], 1u); break; } }
    }
    nloc = mine > 0u ? mine : 1u; nx = cnt > 0u ? cnt : 1u;
}

__device__ __forceinline__ void xcd_barrier(const XcdBarrier& b) {
    asm volatile("s_waitcnt vmcnt(0)" ::: "memory");
    __syncthreads();
    if (threadIdx.x == 0) {
        unsigned* bar = b.bar;
        __builtin_amdgcn_s_waitcnt(0);
        unsigned nloc = b.st[0], nx = b.st[1];
        if (nloc == 0u) { xcd_barrier_complete(bar, b.x, nloc, nx); b.st[0] = nloc; b.st[1] = nx; }
        const unsigned old = xb_add(&bar[XB_XSUB(b.x)], 1u);
        const unsigned gen = old / nloc;
        if (old + 1u == (gen + 1u) * nloc) {
            __builtin_amdgcn_fence(__ATOMIC_RELEASE, "agent");
            asm volatile("s_waitcnt vmcnt(0)" ::: "memory");
            const unsigned og = xb_add(&bar[XB_TOP], 1u);
            const unsigned tg = og / nx;
            if (og + 1u == (tg + 1u) * nx) xb_add(&bar[XB_TOPGEN], 1u);
            else XB_SPIN(xb_ld(&bar[XB_TOPGEN]) == tg, bar);
            __builtin_amdgcn_fence(__ATOMIC_ACQUIRE, "agent");
            xb_add(&bar[XB_XGEN(b.x)], 1u);
            asm volatile("s_waitcnt vmcnt(0)" ::: "memory");
        } else {
            XB_SPIN(xb_ld(&bar[XB_XGEN(b.x)]) == gen, bar);
            __builtin_amdgcn_fence(__ATOMIC_ACQUIRE, "agent");
            asm volatile("s_waitcnt vmcnt(0)" ::: "memory");
        }
    }
    __syncthreads();
}


struct Ctx { LAS unsigned char* lds; int tid, lane, wave, bid, G; };

__device__ __forceinline__ float wave_sum(float v) {
#pragma unroll
    for (int o = 1; o < 64; o <<= 1) v += __shfl_xor(v, o);
    return v;
}
__device__ __forceinline__ float sum16(float v) {
#define SUM16_ROR(n) v += __builtin_bit_cast(float, __builtin_amdgcn_update_dpp(0, __builtin_bit_cast(int, v), 0x120 + (n), 0xf, 0xf, false))
    SUM16_ROR(8); SUM16_ROR(4); SUM16_ROR(2); SUM16_ROR(1); return v;
#undef SUM16_ROR
}
__device__ __forceinline__ float siluf(float x) { return x * __builtin_amdgcn_rcpf(1.f + __expf(-x)); }

#ifndef MIX_MFMA
#define MIX_MFMA 1
#endif
#if MIX_MFMA
typedef short v4i16_t __attribute__((ext_vector_type(4)));
template <bool TR> __device__ __forceinline__ bf16x8 ldfrag(const LAS bf16* T, int ld, int x0, int k0, int lane) {
    const int g = lane >> 4, c = lane & 15;
    if constexpr (!TR) { return *(const LAS bf16x8*)(T + (x0 + c) * ld + k0 + 8 * g); }
    else {
        const int q = c >> 2, p = c & 3;
        const LAS bf16* p0 = T + (k0 + 8 * g + q) * ld + x0 + 4 * p;
        const s16x4 lo = __builtin_bit_cast(s16x4, __builtin_amdgcn_ds_read_tr16_b64_v4i16((LAS v4i16_t*)p0));
        const s16x4 hi = __builtin_bit_cast(s16x4, __builtin_amdgcn_ds_read_tr16_b64_v4i16((LAS v4i16_t*)(p0 + 4 * ld)));
        bf16x8 r; r[0] = lo[0]; r[1] = lo[1]; r[2] = lo[2]; r[3] = lo[3]; r[4] = hi[0]; r[5] = hi[1]; r[6] = hi[2]; r[7] = hi[3]; return r;
    }
}
#endif
template <int K, bool TA, bool TB>
__device__ __forceinline__ void mm16(f32x4& acc, const LAS bf16* A, int lda, int m0, const LAS bf16* B, int ldb, int n0, int lane) {
#if MIX_MFMA
#pragma unroll
    for (int k0 = 0; k0 < K; k0 += 32) {
        const bf16x8 a = ldfrag<TA>(A, lda, m0, k0, lane), b = ldfrag<!TB>(B, ldb, n0, k0, lane);
        acc = __builtin_amdgcn_mfma_f32_16x16x32_bf16(a, b, acc, 0, 0, 0);
    }
#else
    const int g = lane >> 4, c = lane & 15;
#pragma unroll 4
    for (int k = 0; k < K; ++k) {
        const float bv = bf2f(TB ? B[(n0 + c) * ldb + k] : B[k * ldb + n0 + c]);
#pragma unroll
        for (int r = 0; r < 4; ++r) { const float av = bf2f(TA ? A[k * lda + m0 + 4 * g + r] : A[(m0 + 4 * g + r) * lda + k]); acc[r] += av * bv; }
    }
#endif
}

struct TrItem { const float* W; bf16* WT; int K, N, kb, nb; bool perm; };
__device__ __forceinline__ void tr_issue(f32x4 (&v)[16], const TrItem& t, int lane) {
    const int r4 = lane >> 4, c4 = (lane & 15) * 4;
    const bool ok = 64 * t.nb + c4 < t.N;
    const float* src = t.W + (size_t)(64 * t.kb + r4) * t.N + 64 * t.nb + c4;
#pragma unroll
    for (int i = 0; i < 16; ++i) v[i] = ok ? *(const f32x4*)(src + (size_t)(4 * i) * t.N) : (f32x4){0.f, 0.f, 0.f, 0.f};
}
__device__ __forceinline__ void tr_finish(const f32x4 (&v)[16], const TrItem& t, LAS float* scr, int lane) {
    const int k0 = 64 * t.kb, n0 = 64 * t.nb;
    const int r4 = lane >> 4, c4 = (lane & 15) * 4;
#pragma unroll
    for (int i = 0; i < 16; ++i) { LAS float* d = scr + (4 * i + r4) * 65 + c4; d[0] = v[i].x; d[1] = v[i].y; d[2] = v[i].z; d[3] = v[i].w; }
    asm volatile("s_waitcnt lgkmcnt(0)" ::: "memory");
    const int kc = lane & 7;
#pragma unroll
    for (int j = 0; j < 8; ++j) { const int n = (lane >> 3) + 8 * j; const LAS float* s = scr + (8 * kc) * 65 + n;
        int nout = n0 + n;
        if (t.perm && nout < 1536) { const int w = nout & 127; nout = (nout & ~127) + ((w < 64) ? 2 * w : 2 * (w - 64) + 1); }
        v4u o; o.x = pk2(s[0 * 65], s[1 * 65]); o.y = pk2(s[2 * 65], s[3 * 65]); o.z = pk2(s[4 * 65], s[5 * 65]); o.w = pk2(s[6 * 65], s[7 * 65]);
        *(v4u*)(t.WT + pg8::tiled_off(nout, k0 + 8 * kc, t.K)) = o; }
    asm volatile("s_waitcnt lgkmcnt(0)" ::: "memory");
}

struct P {
    const float *x, *c, *w_ada, *b_ada, *g_mix, *g_mlp, *w_in, *w_gate, *b_gate, *w_pool, *s_pool, *w_out, *w_up, *w_down, *g_final;
    float* out;
    float *mod, *modp, *gch, *gb; unsigned* rot;
    bf16 *win, *wout, *wup, *wdn, *XN, *Z, *MIX, *H, *rprev, *sprev, *uret, *ugla, *X;
};

__device__ __forceinline__ void phase_x_to_bf16(const Ctx& C, const float* x, bf16* X);
__device__ __forceinline__ void phase_prologue(const Ctx& C, const P& p) {
    phase_x_to_bf16(C, p.x, p.X);
    {
        const int gt = C.bid * NTHR + C.tid, NT = C.G * NTHR;
        for (int i = gt; i < SEQ * 64; i += NT) {
            const int pos = i >> 6, f = i & 63;
            const double inv = exp2(-(double)f * (13.287712379549449 / 64.0));
            const double ang = (double)pos * inv;
            const double k = rint(ang * 0.15915494309189535);
            const float r = (float)(ang - k * 6.283185307179586);
            p.rot[i] = pg8::res_pk(cosf(r), sinf(r));
        }
    }
    {
        LAS float* scr = (LAS float*)(C.lds + C.wave * 16640);
        const int gw = C.bid * NWAVES + C.wave, NGW = C.G * NWAVES;
        constexpr int I_IN = (DM / 64) * (NZ / 64), I_OUT = (DM / 64) * (DM / 64), I_UP = (DM / 64) * (DFF / 64), I_DN = (DFF / 64) * (DM / 64);
        constexpr int I_L = I_IN + I_OUT + I_UP + I_DN;
#define TR_ITEM(t, it_) do { const int l_ = (it_) / I_L; int r_ = (it_) % I_L; \
            if (r_ < I_IN) { t = TrItem{p.w_in + (size_t)l_ * DM * NIN, p.win + (size_t)l_ * NZ * DM, DM, NIN, r_ / (NZ / 64), r_ % (NZ / 64), true}; } \
            else if ((r_ -= I_IN) < I_OUT) { t = TrItem{p.w_out + (size_t)l_ * DM * DM, p.wout + (size_t)l_ * DM * DM, DM, DM, r_ / (DM / 64), r_ % (DM / 64), false}; } \
            else if ((r_ -= I_OUT) < I_UP) { t = TrItem{p.w_up + (size_t)l_ * DM * DFF, p.wup + (size_t)l_ * DFF * DM, DM, DFF, r_ / (DFF / 64), r_ % (DFF / 64), false}; } \
            else { r_ -= I_UP; t = TrItem{p.w_down + (size_t)l_ * DFF * DM, p.wdn + (size_t)l_ * DM * DFF, DFF, DM, r_ / (DM / 64), r_ % (DM / 64), false}; } } while (0)
        int it = gw;
        if (it < DEPTH * I_L) {
            TrItem cur, nxt; f32x4 v[16], vn[16];
            TR_ITEM(cur, it); tr_issue(v, cur, C.lane);
            for (;;) {
                const int ni = it + NGW; const bool more = ni < DEPTH * I_L;
                if (more) { TR_ITEM(nxt, ni); tr_issue(vn, nxt, C.lane); }
                tr_finish(v, cur, scr, C.lane);
                if (!more) break;
                cur = nxt; it = ni;
#pragma unroll
                for (int i = 0; i < 16; ++i) v[i] = vn[i];
            }
        }
#undef TR_ITEM
    }
    __syncthreads();
    LAS float* sc = (LAS float*)C.lds;
    for (int i = C.tid; i < BATCH * DM; i += NTHR) sc[i] = siluf(p.c[i]);
    __syncthreads();
    {
        const int gw = C.bid * NWAVES + C.wave, NGW = C.G * NWAVES;
        constexpr int NB = NMOD / 256, KC = DM / KS_ADA;
        for (int it = gw; it < DEPTH * NB * KS_ADA; it += NGW) {
            const int ks = it % KS_ADA, nb = (it / KS_ADA) % NB, l = it / (KS_ADA * NB);
            const float* wp = p.w_ada + ((size_t)l * DM + (size_t)ks * KC) * NMOD + nb * 256 + C.lane * 4;
            f32x4 a0 = {0.f, 0.f, 0.f, 0.f}, a1 = a0, a2 = a0, a3 = a0;
#pragma unroll 16
            for (int k = 0; k < KC; ++k) {
                const f32x4 w = *(const f32x4*)(wp + (size_t)k * NMOD);
                const int kk = ks * KC + k;
                a0 += w * sc[0 * DM + kk]; a1 += w * sc[1 * DM + kk]; a2 += w * sc[2 * DM + kk]; a3 += w * sc[3 * DM + kk];
            }
            float* o = p.modp + (((size_t)ks * DEPTH + l) * BATCH) * NMOD + nb * 256 + C.lane * 4;
            *(f32x4*)(o + 0 * NMOD) = a0; *(f32x4*)(o + 1 * NMOD) = a1; *(f32x4*)(o + 2 * NMOD) = a2; *(f32x4*)(o + 3 * NMOD) = a3;
        }
    }
    __syncthreads();
}

__device__ __forceinline__ void phase_modfin(const Ctx& C, const P& p) {
    const int gt = C.bid * NTHR + C.tid, NT = C.G * NTHR;
    for (int i = gt; i < DEPTH * BATCH * NMOD; i += NT) {
        const int n = i % NMOD, l = i / (BATCH * NMOD);
        float s = p.b_ada[l * NMOD + n];
#pragma unroll
        for (int ks = 0; ks < KS_ADA; ++ks) s += p.modp[(size_t)ks * DEPTH * BATCH * NMOD + i];
        p.mod[i] = s;
    }
}

__device__ __forceinline__ void phase_norm_mod(const Ctx& C, const bf16* x, const float* g, const float* sh, const float* scl, bf16* xn) {
    const int gw = C.bid * NWAVES + C.wave, NGW = C.G * NWAVES;
    for (int r0 = gw * 8; r0 < M; r0 += NGW * 8) {
        const int b = r0 / SEQ;
        f32x4 a[8], s[8];
#pragma unroll
        for (int j = 0; j < 4; ++j)
#pragma unroll
            for (int hh = 0; hh < 2; ++hh) { const int col = (C.lane + 64 * j) * 8 + 4 * hh; const f32x4 gv = *(const f32x4*)(g + col), sv = *(const f32x4*)(scl + (size_t)b * NMOD + col);
                a[2 * j + hh] = gv * (sv + 1.0f); s[2 * j + hh] = *(const f32x4*)(sh + (size_t)b * NMOD + col); }
        v4u qn[4];
#pragma unroll
        for (int j = 0; j < 4; ++j) qn[j] = *(const v4u*)(x + pg8::xblk_off(r0, (C.lane + 64 * j) * 8, DM));
#pragma unroll 1
        for (int r = r0; r < r0 + 8; ++r) {
            v4u qc[4];
#pragma unroll
            for (int j = 0; j < 4; ++j) qc[j] = qn[j];
            if (r + 1 < r0 + 8) {
#pragma unroll
                for (int j = 0; j < 4; ++j) qn[j] = *(const v4u*)(x + pg8::xblk_off(r + 1, (C.lane + 64 * j) * 8, DM)); }
            f32x4 v[8]; float ss = 0.f;
#pragma unroll
            for (int j = 0; j < 4; ++j) { const v4u q = qc[j];
                v[2 * j] = (f32x4){pg8::res_lo(q.x), pg8::res_hi(q.x), pg8::res_lo(q.y), pg8::res_hi(q.y)}; v[2 * j + 1] = (f32x4){pg8::res_lo(q.z), pg8::res_hi(q.z), pg8::res_lo(q.w), pg8::res_hi(q.w)}; }
#pragma unroll
            for (int j = 0; j < 8; ++j) ss += (v[j].x * v[j].x + v[j].y * v[j].y) + (v[j].z * v[j].z + v[j].w * v[j].w);
            const float rstd = __builtin_amdgcn_rsqf(wave_sum(ss) * (1.0f / DM) + EPS);
#pragma unroll
            for (int j = 0; j < 4; ++j) { const f32x4 y0 = v[2 * j] * rstd * a[2 * j] + s[2 * j], y1 = v[2 * j + 1] * rstd * a[2 * j + 1] + s[2 * j + 1];
                v4u w; w.x = pk2(y0.x, y0.y); w.y = pk2(y0.z, y0.w); w.z = pk2(y1.x, y1.y); w.w = pk2(y1.z, y1.w);
                *(v4u*)(xn + (size_t)r * DM + (C.lane + 64 * j) * 8) = w; }
        }
    }
}
__device__ __forceinline__ void phase_norm_final(const Ctx& C, const bf16* x, const float* g, float* out) {
    const int gw = C.bid * NWAVES + C.wave, NGW = C.G * NWAVES;
    if (gw >= M) return;
    v4u qn[4];
#pragma unroll
    for (int j = 0; j < 4; ++j) qn[j] = *(const v4u*)(x + pg8::xblk_off(gw, (C.lane + 64 * j) * 8, DM));
#pragma unroll 1
    for (int r = gw; r < M; r += NGW) {
        v4u qc[4];
#pragma unroll
        for (int j = 0; j < 4; ++j) qc[j] = qn[j];
        if (r + NGW < M) {
#pragma unroll
            for (int j = 0; j < 4; ++j) qn[j] = *(const v4u*)(x + pg8::xblk_off(r + NGW, (C.lane + 64 * j) * 8, DM)); }
        f32x4 v[8]; float ss = 0.f;
#pragma unroll
        for (int j = 0; j < 4; ++j) { const v4u q = qc[j];
            v[2 * j] = (f32x4){pg8::res_lo(q.x), pg8::res_hi(q.x), pg8::res_lo(q.y), pg8::res_hi(q.y)}; v[2 * j + 1] = (f32x4){pg8::res_lo(q.z), pg8::res_hi(q.z), pg8::res_lo(q.w), pg8::res_hi(q.w)}; }
#pragma unroll
        for (int j = 0; j < 8; ++j) ss += (v[j].x * v[j].x + v[j].y * v[j].y) + (v[j].z * v[j].z + v[j].w * v[j].w);
        const float rstd = __builtin_amdgcn_rsqf(wave_sum(ss) * (1.0f / DM) + EPS);
#pragma unroll
        for (int j = 0; j < 4; ++j)
#pragma unroll
            for (int hh = 0; hh < 2; ++hh) { const int col = (C.lane + 64 * j) * 8 + 4 * hh; *(f32x4*)(out + (size_t)r * DM + col) = v[2 * j + hh] * rstd * *(const f32x4*)(g + col); }
    }
}
__device__ __forceinline__ void phase_x_to_bf16(const Ctx& C, const float* x, bf16* X) {
    const size_t gt = (size_t)C.bid * NTHR + C.tid, NT = (size_t)C.G * NTHR;
#pragma unroll 4
    for (size_t i = gt; i < (size_t)M * DM / 8; i += NT) { const f32x4 a = *(const f32x4*)(x + i * 8), b = *(const f32x4*)(x + i * 8 + 4);
        v4u w; w.x = pg8::res_pk(a.x, a.y); w.y = pg8::res_pk(a.z, a.w); w.z = pg8::res_pk(b.x, b.y); w.w = pg8::res_pk(b.z, b.w); *(v4u*)(X + pg8::xblk_off((int)(i / (DM / 8)), (int)(i % (DM / 8)) * 8, DM)) = w; }
}

constexpr int LDT = 136;
#define LDS_BAR() do { asm volatile("s_waitcnt lgkmcnt(0)" ::: "memory"); __builtin_amdgcn_s_barrier(); asm volatile("" ::: "memory"); } while (0)
__device__ __forceinline__ float ret_log_g(int h) { return log1pf(-exp2f(-5.0f - (float)h)); }
__device__ __forceinline__ f32x4 mfma16(bf16x8 a, bf16x8 b, f32x4 c) { return __builtin_amdgcn_mfma_f32_16x16x32_bf16(a, b, c, 0, 0, 0); }

__device__ __forceinline__ int fresh_tid(int tid) { asm volatile("" : "+v"(tid)); return tid; }

template <int CHUNKS, bool BLK> __device__ __forceinline__ void tile_jc(int it, int& j, int& c8) {
    if constexpr (BLK) { constexpr int G = CHUNKS / 4; const int sub = it >> 6; j = (sub / G) * 16 + ((it & 63) >> 2); c8 = ((sub % G) * 4 + (it & 3)) * 8; }
    else { j = it / CHUNKS; c8 = (it % CHUNKS) * 8; }
}
template <int TOTAL, int CHUNKS, bool BLK = false>
struct RawTile {
    static constexpr int NV = (TOTAL + NTHR - 1) / NTHR;
    static_assert(!BLK || (CHUNKS % 4 == 0 && TOTAL % 64 == 0), "blocked tiles are whole 16 x 32 sub-blocks");
    v4u v[NV];
    __device__ __forceinline__ void issue(const bf16* src, size_t spitch, int tid) {
#pragma unroll
        for (int k = 0; k < NV; ++k) { const int it = tid + k * NTHR;
            if ((TOTAL % NTHR == 0) || it < TOTAL) { if constexpr (BLK) v[k] = *(const v4u*)(src + (unsigned)(it * 8)); else { int j, c8; tile_jc<CHUNKS, false>(it, j, c8); v[k] = *(const v4u*)(src + (unsigned)(j * (int)spitch + c8)); } } }
    }
    __device__ __forceinline__ void store(LAS bf16* dst, int ld, int tid) const {
#pragma unroll
        for (int k = 0; k < NV; ++k) { const int it = tid + k * NTHR;
            if ((TOTAL % NTHR == 0) || it < TOTAL) { int j, c8; tile_jc<CHUNKS, BLK>(it, j, c8); *(LAS v4u*)(dst + j * ld + c8) = v[k]; } }
    }
};

struct RetARaw { RawTile<2048, 16, true> k, v; };
__device__ __forceinline__ void retA_issue(RetARaw& R, const P& p, int item, int tid) {
    const int n = item % RNC, bh = item / RNC; const size_t to = ((size_t)bh * SEQ + n * RC) * RD;
    R.k.issue(p.Z + ZO_K + to, RD, tid); R.v.issue(p.Z + ZO_V + to, RD, tid);
}
__device__ __forceinline__ void retA_store(const RetARaw& R, LAS bf16* Kt, LAS bf16* Vt, float lg, int tid) {
    R.k.store(Kt, LDT, tid);
#pragma unroll
    for (int k = 0; k < 4; ++k) { const int it = tid + k * NTHR; int j, c8; tile_jc<16, true>(it, j, c8); const float z = __expf((float)(RC - 1 - j) * lg);
        v4u a = R.v.v[k];
#pragma unroll
        for (int e = 0; e < 4; ++e) a[e] = pk2(bflo(a[e]) * z, bfhi(a[e]) * z);
        *(LAS v4u*)(Vt + j * LDT + c8) = a; }
}
__device__ __forceinline__ void retA_compute(const LAS bf16* Kt, const LAS bf16* Vt, bf16* U, int wave, int lane) {
    const int g = lane >> 4, c = lane & 15;
    bf16x8 bv[4], ak[2][4];
#pragma unroll
    for (int s = 0; s < 4; ++s) { bv[s] = ldfrag<true>(Vt, LDT, wave * 16, 32 * s, lane); ak[0][s] = ldfrag<true>(Kt, LDT, 0, 32 * s, lane); }
#pragma unroll
    for (int db = 0; db < 8; ++db) {
        if (db + 1 < 8) {
#pragma unroll
            for (int s = 0; s < 4; ++s) ak[(db + 1) & 1][s] = ldfrag<true>(Kt, LDT, (db + 1) * 16, 32 * s, lane); }
        __builtin_amdgcn_sched_barrier(0);
        f32x4 acc = {0.f, 0.f, 0.f, 0.f};
#pragma unroll
        for (int s = 0; s < 4; ++s) acc = mfma16(ak[db & 1][s], bv[s], acc);
        v2u o; o.x = pk2(acc[0], acc[1]); o.y = pk2(acc[2], acc[3]);
        *(v2u*)(U + (unsigned)((wave * 16 + c) * RD + db * 16 + 4 * g)) = o;
        __builtin_amdgcn_sched_barrier(0);
    }
}
__device__ __forceinline__ void phase_retA(const Ctx& C, const P& p) {
    constexpr int N = BATCH * RH * RNC;
    LAS bf16* Kt = (LAS bf16*)C.lds; LAS bf16* Vt = Kt + 128 * LDT;
    int it = C.bid; if (it >= N) return;
    RetARaw R; retA_issue(R, p, it, C.tid);
    for (;;) {
        const float lg = ret_log_g((it / RNC) % RH);
        retA_store(R, Kt, Vt, lg, fresh_tid(C.tid));
        LDS_BAR();
        const int nx = it + C.G;
        if (nx < N) retA_issue(R, p, nx, fresh_tid(C.tid));
        retA_compute(Kt, Vt, p.uret + (size_t)it * RD * RD, C.wave, fresh_tid(C.tid) & 63);
        LDS_BAR();
        if (nx >= N) break;
        it = nx;
    }
}

struct RetBRaw { RawTile<2048, 16, true> q, k, v; RawTile<2048, 16> r; };
__device__ __forceinline__ void retB_issue(RetBRaw& R, const P& p, int item, int tid) {
    const int n = item % RNC, bh = item / RNC; const size_t to = ((size_t)bh * SEQ + n * RC) * RD;
    R.q.issue(p.Z + ZO_Q + to, RD, tid); R.k.issue(p.Z + ZO_K + to, RD, tid);
    R.v.issue(p.Z + ZO_V + to, RD, tid); R.r.issue(p.rprev + (size_t)item * RD * RD, RD, tid);
}
constexpr int OLD = 132;
static_assert(128 * OLD * 4 <= 2 * 128 * LDT * 2, "staged output fits over Q and P");
__device__ __forceinline__ void retB_compute(LAS bf16* Qt, LAS bf16* Kt, LAS bf16* Vt, LAS bf16* Rt, const P& p, int item, int w, int lane, int tid) {
    const int n = item % RNC, h = (item / RNC) % RH, b = item / (RNC * RH);
    const int t0 = b * SEQ + n * RC; const float lg = ret_log_g(h); const float scale = 0.08838834764831845f;
    const int g = lane >> 4, c = lane & 15;
    f32x4 s[8];
    {
        bf16x8 a[4], bq[2][4];
#pragma unroll
        for (int s4 = 0; s4 < 4; ++s4) a[s4] = ldfrag<false>(Kt, LDT, w * 16, 32 * s4, lane);
        if (w == 0) {
#pragma unroll
            for (int s4 = 0; s4 < 4; ++s4) bq[0][s4] = ldfrag<false>(Qt, LDT, 0, 32 * s4, lane); }
#pragma unroll
        for (int ib = 0; ib < 8; ++ib) {
            if (ib + 1 < 8 && ib + 1 >= w) {
#pragma unroll
                for (int s4 = 0; s4 < 4; ++s4) bq[(ib + 1) & 1][s4] = ldfrag<false>(Qt, LDT, (ib + 1) * 16, 32 * s4, lane); }
            __builtin_amdgcn_sched_barrier(0);
            if (ib >= w) { s[ib] = mfma16(a[0], bq[ib & 1][0], (f32x4){0.f, 0.f, 0.f, 0.f});
#pragma unroll
                for (int s4 = 1; s4 < 4; ++s4) s[ib] = mfma16(a[s4], bq[ib & 1][s4], s[ib]); }
            __builtin_amdgcn_sched_barrier(0);
        }
    }
    RawTile<2048, 16, true> G; G.issue(p.Z + ZO_G + ((size_t)(item / RNC) * SEQ + n * RC) * RD, RD, tid);
    LDS_BAR();
    LAS bf16* Pt = Kt;
    {
        float rj[4]; const float ec = scale * __expf((float)c * lg);
#pragma unroll
        for (int r = 0; r < 4; ++r) rj[r] = __expf(-(float)(w * 16 + 4 * g + r) * lg);
#pragma unroll
        for (int ib = 0; ib < 8; ++ib) {
            v2u o = {0u, 0u};
            if (ib >= w) { const float ci = ec * __expf((float)(16 * ib) * lg); float v[4];
#pragma unroll
                for (int r = 0; r < 4; ++r) { v[r] = s[ib][r] * ci * rj[r]; if (ib == w && c < 4 * g + r) v[r] = 0.f; }
                o.x = pk2(v[0], v[1]); o.y = pk2(v[2], v[3]); }
            *(LAS v2u*)(Pt + (ib * 16 + c) * LDT + w * 16 + 4 * g) = o;
        }
    }
    LDS_BAR();
    f32x4 o[8];
    {
        const int smax = w >> 1;
        bf16x8 ap[4], aq[4];
#pragma unroll
        for (int s4 = 0; s4 < 4; ++s4) { aq[s4] = ldfrag<false>(Qt, LDT, w * 16, 32 * s4, lane); if (s4 <= smax) ap[s4] = ldfrag<false>(Pt, LDT, w * 16, 32 * s4, lane); }
        float xi[4];
#pragma unroll
        for (int r = 0; r < 4; ++r) xi[r] = scale * __expf((float)(w * 16 + 4 * g + r + 1) * lg);
        bf16x8 fv[4], fr[2][4];
#pragma unroll
        for (int s4 = 0; s4 < 4; ++s4) fr[0][s4] = ldfrag<false>(Rt, LDT, 0, 32 * s4, lane);
#pragma unroll
        for (int eb = 0; eb < 8; ++eb) {
#pragma unroll
            for (int s4 = 0; s4 < 4; ++s4) { if (s4 <= smax) fv[s4] = ldfrag<true>(Vt, LDT, eb * 16, 32 * s4, lane); }
            if (eb + 1 < 8) {
#pragma unroll
                for (int s4 = 0; s4 < 4; ++s4) fr[(eb + 1) & 1][s4] = ldfrag<false>(Rt, LDT, (eb + 1) * 16, 32 * s4, lane); }
            __builtin_amdgcn_sched_barrier(0);
            f32x4 cr = mfma16(aq[0], fr[eb & 1][0], (f32x4){0.f, 0.f, 0.f, 0.f});
#pragma unroll
            for (int s4 = 1; s4 < 4; ++s4) cr = mfma16(aq[s4], fr[eb & 1][s4], cr);
            f32x4 in = mfma16(ap[0], fv[0], (f32x4){0.f, 0.f, 0.f, 0.f});
#pragma unroll
            for (int s4 = 1; s4 < 4; ++s4) { if (s4 <= smax) in = mfma16(ap[s4], fv[s4], in); }
#pragma unroll
            for (int r = 0; r < 4; ++r) o[eb][r] = in[r] + xi[r] * cr[r];
            __builtin_amdgcn_sched_barrier(0);
        }
    }
#pragma unroll
    for (int r = 0; r < 4; ++r) {
        float sm = 0.f;
#pragma unroll
        for (int eb = 0; eb < 8; ++eb) sm += o[eb][r];
        const float mean = sum16(sm) * (1.0f / RD);
        float q = 0.f;
#pragma unroll
        for (int eb = 0; eb < 8; ++eb) { const float d = o[eb][r] - mean; q += d * d; }
        const float rstd = 1.0f / sqrtf(sum16(q) * (1.0f / RD) + EPS);
#pragma unroll
        for (int eb = 0; eb < 8; ++eb) o[eb][r] = (o[eb][r] - mean) * rstd;
    }
    LDS_BAR();
    LAS float* Ot = (LAS float*)Qt;
#pragma unroll
    for (int r = 0; r < 4; ++r)
#pragma unroll
        for (int eb = 0; eb < 8; ++eb) Ot[(w * 16 + 4 * g + r) * OLD + eb * 16 + c] = o[eb][r];
    LDS_BAR();
#pragma unroll
    for (int k = 0; k < 4; ++k) { const int it = tid + k * NTHR; int j, c8; tile_jc<16, true>(it, j, c8);
        const f32x4 y0 = *(const LAS f32x4*)(Ot + j * OLD + c8), y1 = *(const LAS f32x4*)(Ot + j * OLD + c8 + 4); const v4u gt = G.v[k];
        v4u ov; ov.x = pk2(y0.x * bflo(gt.x), y0.y * bfhi(gt.x)); ov.y = pk2(y0.z * bflo(gt.y), y0.w * bfhi(gt.y)); ov.z = pk2(y1.x * bflo(gt.z), y1.y * bfhi(gt.z)); ov.w = pk2(y1.z * bflo(gt.w), y1.w * bfhi(gt.w));
        *(v4u*)(p.MIX + (size_t)t0 * DM + MIX_RET + h * RD + (unsigned)(j * DM + c8)) = ov; }
}
__device__ __forceinline__ void phase_retB(const Ctx& C, const P& p) {
    constexpr int N = BATCH * RH * RNC;
    LAS bf16* Qt = (LAS bf16*)C.lds; LAS bf16* Kt = Qt + 128 * LDT; LAS bf16* Vt = Kt + 128 * LDT; LAS bf16* Rt = Vt + 128 * LDT;
    int it = C.bid; if (it >= N) return;
    RetBRaw R; retB_issue(R, p, it, C.tid);
    for (;;) {
        { const int t = fresh_tid(C.tid); R.q.store(Qt, LDT, t); R.k.store(Kt, LDT, t); R.v.store(Vt, LDT, t); R.r.store(Rt, LDT, t); }
        LDS_BAR();
        const int nx = it + C.G;
        if (nx < N) retB_issue(R, p, nx, fresh_tid(C.tid));
        { const int t = fresh_tid(C.tid); retB_compute(Qt, Kt, Vt, Rt, p, it, C.wave, t & 63, t); }
        LDS_BAR();
        if (nx >= N) break;
        it = nx;
    }
}

constexpr int BLD = 100, KLD = 104, VLD = 200, PLD = 72, GZLD = 32, OLDG = 196;
constexpr int G_BC = 0, G_GZ = G_BC + GC * BLD * 4  , G_SEG = G_GZ + GC * GZLD * 2  , G_WG = G_SEG + 4 * GDK * 4  , G_QD = G_WG + GDK * GZLD * 2  ,
              G_KI = G_QD + GC * KLD * 2  , G_V = G_KI + GC * KLD * 2  , G_SP = G_V + GC * VLD * 2  , G_P = G_SP + GDV * KLD * 2  , G_SSQ = G_P + GC * PLD * 2  ,
              G_END = G_SSQ + GC * 2 * 4;
static_assert(G_QD + GC * OLDG * 4 <= G_SP, "pass B's staged output fits over the dead q / k / v tiles");
static_assert(G_END <= RING_BYTES && (G_GZ % 16) == 0 && (G_WG % 16) == 0 && (G_QD % 16) == 0 && (G_KI % 16) == 0 && (G_V % 16) == 0 && (G_SP % 16) == 0 && (G_P % 16) == 0, "GLA LDS map");
struct GlaGateRaw { v4u gz; float wv[4]; float bias[3]; };
__device__ __forceinline__ void glaG_issue(GlaGateRaw& R, const P& p, int l, int t0, int h, int tid, int wave, int lane) {
    if (tid < 128) R.gz = *(const v4u*)(p.Z + ZO_GZ + (size_t)t0 * 16 + tid * 8);
    if (tid < 4 * GDK) { const int d = tid % GDK, rq = tid / GDK;
#pragma unroll
        for (int r = 0; r < 4; ++r) R.wv[r] = p.w_gate[((size_t)l * 16 + 4 * rq + r) * (GH * GDK) + h * GDK + d]; }
#pragma unroll
    for (int i = 0; i < 3; ++i) R.bias[i] = p.b_gate[l * (GH * GDK) + h * GDK + ((wave & 1) * 3 + i) * 16 + (lane & 15)];
}
__device__ __forceinline__ void gla_gates(const Ctx& C, const GlaGateRaw& R) {
    LAS float* bc = (LAS float*)(C.lds + G_BC); LAS bf16* gzs = (LAS bf16*)(C.lds + G_GZ); LAS float* seg = (LAS float*)(C.lds + G_SEG); LAS bf16* wgt = (LAS bf16*)(C.lds + G_WG);
    if (C.tid < 128) *(LAS v4u*)(gzs + (C.tid >> 1) * GZLD + (C.tid & 1) * 8) = R.gz;
    if (C.tid < 4 * GDK) { v2u o; o.x = pk2(R.wv[0], R.wv[1]); o.y = pk2(R.wv[2], R.wv[3]); *(LAS v2u*)(wgt + (C.tid % GDK) * GZLD + 4 * (C.tid / GDK)) = o; }
    LDS_BAR();
    {
        const int g = C.lane >> 4, c = C.lane & 15, jb = C.wave >> 1;
        const bf16x8 a = ldfrag<false>(gzs, GZLD, jb * 16, 0, C.lane);
#pragma unroll
        for (int i = 0; i < 3; ++i) { const int db = (C.wave & 1) * 3 + i;
            const f32x4 x = mfma16(a, ldfrag<false>(wgt, GZLD, db * 16, 0, C.lane), (f32x4){0.f, 0.f, 0.f, 0.f});
#pragma unroll
            for (int r = 0; r < 4; ++r) { const float xg = x[r] + R.bias[i];
                bc[(jb * 16 + 4 * g + r) * BLD + db * 16 + c] = (fminf(xg, 0.f) - __logf(1.0f + __expf(-fabsf(xg)))) * (1.0f / 16.0f); }
        }
    }
    LDS_BAR();
    const int d = C.tid % GDK, sg = C.tid / GDK;
    float bl[16]; float run = 0.f;
    if (C.tid < 4 * GDK) {
#pragma unroll
        for (int jj = 0; jj < 16; ++jj) { run += bc[(sg * 16 + jj) * BLD + d]; bl[jj] = run; }
        seg[sg * GDK + d] = run;
    }
    LDS_BAR();
    if (C.tid < 4 * GDK) {
        float pre = 0.f;
        for (int s = 0; s < sg; ++s) pre += seg[s * GDK + d];
#pragma unroll
        for (int jj = 0; jj < 16; ++jj) bc[(sg * 16 + jj) * BLD + d] = pre + bl[jj];
    }
    LDS_BAR();
}
__device__ __forceinline__ void gla_store_qk(const Ctx& C, LAS bf16* dst, const RawTile<768, 12, true>& R, float mul, float sgn, bool addlast) {
    const LAS float* bc = (const LAS float*)(C.lds + G_BC);
#pragma unroll
    for (int k = 0; k < 2; ++k) { const int it = C.tid + k * NTHR;
        if (it < 768) { int j, c8; tile_jc<12, true>(it, j, c8); const v4u a = R.v[k]; v4u o;
#pragma unroll
            for (int e = 0; e < 4; ++e) {
                const int d0 = c8 + 2 * e;
                const float e0 = sgn * bc[j * BLD + d0] + (addlast ? bc[63 * BLD + d0] : 0.f), e1 = sgn * bc[j * BLD + d0 + 1] + (addlast ? bc[63 * BLD + d0 + 1] : 0.f);
                o[e] = pk2(bflo(a[e]) * mul * __expf(e0), bfhi(a[e]) * mul * __expf(e1));
            }
            *(LAS v4u*)(dst + j * KLD + c8) = o; } }
}
__device__ __forceinline__ void gla_store_qk_reg(int tid, LAS bf16* dst, const RawTile<768, 12, true>& R, const f32x4 (&gb)[2][2], float mul, float sgn) {
#pragma unroll
    for (int k = 0; k < 2; ++k) { const int it = tid + k * NTHR;
        if (it < 768) { int j, c8; tile_jc<12, true>(it, j, c8); const v4u a = R.v[k]; const f32x4 b0 = gb[k][0] * sgn, b1 = gb[k][1] * sgn; v4u o;
            o.x = pk2(bflo(a.x) * mul * __expf(b0.x), bfhi(a.x) * mul * __expf(b0.y)); o.y = pk2(bflo(a.y) * mul * __expf(b0.z), bfhi(a.y) * mul * __expf(b0.w));
            o.z = pk2(bflo(a.z) * mul * __expf(b1.x), bfhi(a.z) * mul * __expf(b1.y)); o.w = pk2(bflo(a.w) * mul * __expf(b1.z), bfhi(a.w) * mul * __expf(b1.w));
            *(LAS v4u*)(dst + j * KLD + c8) = o; } }
}
struct GlaARaw { GlaGateRaw gt; RawTile<768, 12, true> k; RawTile<1536, 24, true> v; };
__device__ __forceinline__ void glaA_issue(GlaARaw& R, const P& p, int l, int item, int tid) {
    const int n = item % GNC, h = (item / GNC) % GH, b = item / (GNC * GH); const int t0 = b * SEQ + n * GC;
    glaG_issue(R.gt, p, l, t0, h, tid, __builtin_amdgcn_readfirstlane(tid >> 6), tid & 63);
    const size_t tr = (size_t)(b * GH + h) * SEQ + n * GC;
    R.k.issue(p.Z + ZO_GK + tr * GDK, GDK, tid); R.v.issue(p.Z + ZO_GV + tr * GDV, GDV, tid);
}
__device__ __forceinline__ void phase_glaA(const Ctx& Cin, const P& p, int l) {
    constexpr int N = BATCH * GH * GNC;
    LAS bf16* kst = (LAS bf16*)(Cin.lds + G_KI); LAS bf16* Vt = (LAS bf16*)(Cin.lds + G_V);
    int it = Cin.bid; if (it >= N) return;
    for (int i = Cin.tid; i < (G_QD - G_GZ) / 4; i += NTHR) ((LAS unsigned*)(Cin.lds + G_GZ))[i] = 0u;
    LDS_BAR();
    GlaARaw R; glaA_issue(R, p, l, it, Cin.tid);
    for (;;) {
        Ctx C = Cin; C.tid = fresh_tid(Cin.tid); C.lane = C.tid & 63;
        const int g = C.lane >> 4, c = C.lane & 15;
        gla_gates(C, R.gt);
        gla_store_qk(C, kst, R.k, 1.0f, -1.0f, true);
        R.v.store(Vt, VLD, C.tid);
        if (C.tid < GDK) p.gch[(size_t)it * GDK + C.tid] = __expf(((const LAS float*)(C.lds + G_BC))[63 * BLD + C.tid]);
#pragma unroll
        for (int k = 0; k < 3; ++k) { const int i2 = C.tid + k * NTHR, j = i2 / 24, c4 = (i2 % 24) * 4;
            *(f32x4*)(p.gb + (size_t)it * (GC * GDK) + (unsigned)(j * GDK + c4)) = *(const LAS f32x4*)((const LAS float*)(C.lds + G_BC) + j * BLD + c4); }
        LDS_BAR();
        const int nx = it + C.G;
        if (nx < N) glaA_issue(R, p, l, nx, C.tid);
        bf16* U = p.ugla + (size_t)it * GDV * GDK;
        {
            bf16x8 fk[2][2], fvv[2][2];
#define GLAA_LOADF(ix, tt_) do { const int t_ = C.wave * 9 + (tt_), eb_ = t_ / 6, db_ = t_ % 6; _Pragma("unroll") for (int s = 0; s < 2; ++s) { \
                fk[ix][s] = ldfrag<true>(kst, KLD, db_ * 16, 32 * s, C.lane); fvv[ix][s] = ldfrag<true>(Vt, VLD, eb_ * 16, 32 * s, C.lane); } } while (0)
            GLAA_LOADF(0, 0);
#pragma unroll
            for (int tt = 0; tt < 9; ++tt) {
                if (tt + 1 < 9) GLAA_LOADF((tt + 1) & 1, tt + 1);
                __builtin_amdgcn_sched_barrier(0);
                const int t = C.wave * 9 + tt, eb = t / 6, db = t % 6;
                f32x4 acc = {0.f, 0.f, 0.f, 0.f};
#pragma unroll
                for (int s = 0; s < 2; ++s) acc = mfma16(fk[tt & 1][s], fvv[tt & 1][s], acc);
                v2u o; o.x = pk2(acc[0], acc[1]); o.y = pk2(acc[2], acc[3]);
                *(v2u*)(U + (unsigned)((eb * 16 + c) * GDK + db * 16 + 4 * g)) = o;
                __builtin_amdgcn_sched_barrier(0);
            }
#undef GLAA_LOADF
        }
        LDS_BAR();
        if (nx >= N) break;
        it = nx;
    }
}
struct GlaBRaw { f32x4 gb[2][2]; RawTile<768, 12, true> q, k; RawTile<1536, 24, true> v; RawTile<2304, 12> sp; };
__device__ __forceinline__ void glaB_issue(GlaBRaw& R, const P& p, int l, int item, int tid) {
    const int n = item % GNC, h = (item / GNC) % GH, b = item / (GNC * GH); const int t0 = b * SEQ + n * GC;
#pragma unroll
    for (int k = 0; k < 2; ++k) { const int i2 = tid + k * NTHR; if (i2 < 768) { int j, c8; tile_jc<12, true>(i2, j, c8); const float* gp = p.gb + (size_t)item * (GC * GDK) + (unsigned)(j * GDK + c8); R.gb[k][0] = *(const f32x4*)gp; R.gb[k][1] = *(const f32x4*)(gp + 4); } }
    (void)t0; (void)l;
    const size_t tr = (size_t)(b * GH + h) * SEQ + n * GC;
    R.q.issue(p.Z + ZO_GQ + tr * GDK, GDK, tid); R.k.issue(p.Z + ZO_GK + tr * GDK, GDK, tid);
    R.v.issue(p.Z + ZO_GV + tr * GDV, GDV, tid); R.sp.issue(p.sprev + (size_t)item * GDV * GDK, GDK, tid);
}
__device__ __forceinline__ void phase_glaB(const Ctx& Cin, const P& p, int l) {
    constexpr int N = BATCH * GH * GNC;
    LAS bf16* qd = (LAS bf16*)(Cin.lds + G_QD); LAS bf16* ki = (LAS bf16*)(Cin.lds + G_KI); LAS bf16* Vt = (LAS bf16*)(Cin.lds + G_V);
    LAS bf16* Sp = (LAS bf16*)(Cin.lds + G_SP); LAS bf16* Pt = (LAS bf16*)(Cin.lds + G_P); LAS float* ssq = (LAS float*)(Cin.lds + G_SSQ);
    int it = Cin.bid; if (it >= N) return;
    GlaBRaw R; glaB_issue(R, p, l, it, Cin.tid);
    for (;;) {
        Ctx C = Cin; C.tid = fresh_tid(Cin.tid); C.lane = C.tid & 63;
        const int g = C.lane >> 4, c = C.lane & 15, w = C.wave;
        const int n = it % GNC, h = (it / GNC) % GH, b = it / (GNC * GH); const int t0 = b * SEQ + n * GC;
        gla_store_qk_reg(C.tid, qd, R.q, R.gb, 0.10206207261596577f  , 1.0f);
        gla_store_qk_reg(C.tid, ki, R.k, R.gb, 1.0f, -1.0f);
        R.v.store(Vt, VLD, C.tid); R.sp.store(Sp, KLD, C.tid);
        LDS_BAR();
        const int nx = it + C.G;
        if (nx < N) glaB_issue(R, p, l, nx, C.tid);
        const int ib2 = w >> 1, half = w & 1;
        RawTile<1536, 24, true> Gt; Gt.issue(p.Z + ZO_GR + ((size_t)(b * GH + h) * SEQ + n * GC) * GDV, GDV, C.tid);
        {
            const int jb = w >> 1;
            bf16x8 a[3];
#pragma unroll
            for (int s = 0; s < 3; ++s) a[s] = ldfrag<false>(ki, KLD, jb * 16, 32 * s, C.lane);
#pragma unroll
            for (int ii = 0; ii < 2; ++ii) {
                const int ib = (w & 1) * 2 + ii;
                f32x4 sc = {0.f, 0.f, 0.f, 0.f};
                if (ib >= jb) {
#pragma unroll
                    for (int s = 0; s < 3; ++s) sc = mfma16(a[s], ldfrag<false>(qd, KLD, ib * 16, 32 * s, C.lane), sc); }
                const int i = ib * 16 + c; float v[4];
#pragma unroll
                for (int r = 0; r < 4; ++r) { const int j = jb * 16 + 4 * g + r; v[r] = (i >= j) ? sc[r] : 0.f; }
                v2u o; o.x = pk2(v[0], v[1]); o.y = pk2(v[2], v[3]);
                *(LAS v2u*)(Pt + i * PLD + jb * 16 + 4 * g) = o;
            }
        }
        LDS_BAR();
        {
            f32x4 o[6];
            bf16x8 ap[2], aq[3];
#pragma unroll
            for (int s = 0; s < 2; ++s) ap[s] = ldfrag<false>(Pt, PLD, ib2 * 16, 32 * s, C.lane);
#pragma unroll
            for (int s = 0; s < 3; ++s) aq[s] = ldfrag<false>(qd, KLD, ib2 * 16, 32 * s, C.lane);
            bf16x8 fv2[2][2], fs2[2][3];
#define GLAB_LOADF(ix, ee_) do { const int eb_ = half * 6 + (ee_); _Pragma("unroll") for (int s = 0; s < 2; ++s) fv2[ix][s] = ldfrag<true>(Vt, VLD, eb_ * 16, 32 * s, C.lane); \
                _Pragma("unroll") for (int s = 0; s < 3; ++s) fs2[ix][s] = ldfrag<false>(Sp, KLD, eb_ * 16, 32 * s, C.lane); } while (0)
            GLAB_LOADF(0, 0);
#pragma unroll
            for (int ee = 0; ee < 6; ++ee) {
                if (ee + 1 < 6) GLAB_LOADF((ee + 1) & 1, ee + 1);
                __builtin_amdgcn_sched_barrier(0);
                o[ee] = (f32x4){0.f, 0.f, 0.f, 0.f};
#pragma unroll
                for (int s = 0; s < 2; ++s) o[ee] = mfma16(ap[s], fv2[ee & 1][s], o[ee]);
#pragma unroll
                for (int s = 0; s < 3; ++s) o[ee] = mfma16(aq[s], fs2[ee & 1][s], o[ee]);
                __builtin_amdgcn_sched_barrier(0);
            }
#undef GLAB_LOADF
#pragma unroll
            for (int r = 0; r < 4; ++r) {
                float q = 0.f;
#pragma unroll
                for (int ee = 0; ee < 6; ++ee) q += o[ee][r] * o[ee][r];
                q = sum16(q);
                if (c == 0) ssq[(ib2 * 16 + 4 * g + r) * 2 + half] = q;
            }
            LDS_BAR();
            LAS float* Ot = (LAS float*)(C.lds + G_QD);
#pragma unroll
            for (int r = 0; r < 4; ++r) {
                const int i = ib2 * 16 + 4 * g + r;
                const float rstd = __builtin_amdgcn_rsqf((ssq[i * 2] + ssq[i * 2 + 1]) * (1.0f / GDV) + EPS);
#pragma unroll
                for (int ee = 0; ee < 6; ++ee) Ot[i * OLDG + (half * 6 + ee) * 16 + c] = o[ee][r] * rstd;
            }
            LDS_BAR();
#pragma unroll
            for (int k = 0; k < 3; ++k) { const int i2 = C.tid + k * NTHR; int j, c8; tile_jc<24, true>(i2, j, c8);
                const f32x4 y0 = *(const LAS f32x4*)(Ot + j * OLDG + c8), y1 = *(const LAS f32x4*)(Ot + j * OLDG + c8 + 4); const v4u gt = Gt.v[k];
                v4u ov; ov.x = pk2(y0.x * bflo(gt.x), y0.y * bfhi(gt.x)); ov.y = pk2(y0.z * bflo(gt.y), y0.w * bfhi(gt.y)); ov.z = pk2(y1.x * bflo(gt.z), y1.y * bfhi(gt.z)); ov.w = pk2(y1.z * bflo(gt.w), y1.w * bfhi(gt.w));
                *(v4u*)(p.MIX + (size_t)t0 * DM + MIX_GLA + h * GDV + (unsigned)(j * DM + c8)) = ov; }
        }
        LDS_BAR();
        if (nx >= N) break;
        it = nx;
    }
}

struct PoolRaw { RawTile<2304, 16, true> u; f32x4 w[8]; };
__device__ __forceinline__ void pool_issue(PoolRaw& R, const P& p, int l, int item, int tid) {
    const int g4 = item % 4, tt = (item / 4) % (SEQ / 128), b = item / (4 * (SEQ / 128)); const int t0 = b * SEQ + tt * 128;
    const bf16* ub = p.Z + ZO_P + ((size_t)(b * 4 + g4) * SEQ + tt * 128 - 16) * 128;
#pragma unroll
    for (int k = 0; k < 5; ++k) { const int it = tid + k * NTHR;
        if (it < 2304) R.u.v[k] = *(const v4u*)(ub + (unsigned)(it * 8 + ((tt == 0 && it < 256) ? 16 * 128 : 0))); }
    (void)t0;
    const float* wsrc = p.w_pool + ((size_t)l * 4 + g4) * 128 * 128;
#pragma unroll
    for (int k = 0; k < 8; ++k) { const int it = tid + k * NTHR; R.w[k] = *(const f32x4*)(wsrc + (it >> 5) * 128 + (it & 31) * 4); }
}
__device__ __forceinline__ void phase_pool(const Ctx& Cin, const P& p, int l) {
    constexpr int N = BATCH * (SEQ / 128) * 4;
    LAS bf16* U = (LAS bf16*)Cin.lds; LAS bf16* Pl = U + 144 * LDT; LAS bf16* Wp = Pl + 128 * LDT;
    int it = Cin.bid; if (it >= N) return;
    PoolRaw R; pool_issue(R, p, l, it, Cin.tid);
    for (;;) {
        Ctx C = Cin; C.tid = fresh_tid(Cin.tid); C.lane = C.tid & 63;
        const int g = C.lane >> 4, c = C.lane & 15, tb = C.wave;
        const int g4 = it % 4, tt = (it / 4) % (SEQ / 128), b = it / (4 * (SEQ / 128)); const int t0 = b * SEQ + tt * 128, win = 2 << g4;
#pragma unroll
        for (int k = 0; k < 5; ++k) { const int i2 = C.tid + k * NTHR;
            if (i2 < 2304) { int rr, c8; tile_jc<16, true>(i2, rr, c8); v4u a = R.u.v[k]; if (tt == 0 && rr < 16) a = (v4u){0u, 0u, 0u, 0u}; *(LAS v4u*)(U + rr * LDT + c8) = a; } }
#pragma unroll
        for (int k = 0; k < 8; ++k) { const int i2 = C.tid + k * NTHR; const int cc = i2 >> 5, d4 = (i2 & 31) * 4;
            v2u o; o.x = pk2(R.w[k].x, R.w[k].y); o.y = pk2(R.w[k].z, R.w[k].w); *(LAS v2u*)(Wp + cc * LDT + d4) = o; }
        LDS_BAR();
        const int nx = it + C.G;
        if (nx < N) pool_issue(R, p, l, nx, C.tid);
        for (int i2 = C.tid; i2 < 128 * 16; i2 += NTHR) {
            const int t = i2 >> 4, c8 = (i2 & 15) * 8;
            const int pos = tt * 128 + t; const int cnt = (pos + 1 < win) ? pos + 1 : win;
            float s[8];
#pragma unroll
            for (int e = 0; e < 8; ++e) s[e] = 0.f;
            for (int k = 0; k < win; ++k) {
                const v4u a = *(const LAS v4u*)(U + (16 + t - k) * LDT + c8);
#pragma unroll
                for (int e = 0; e < 4; ++e) { s[2 * e] += bflo(a[e]); s[2 * e + 1] += bfhi(a[e]); }
            }
            const v4u a = *(const LAS v4u*)(U + (16 + t) * LDT + c8);
            const float inv = 1.0f / (float)cnt;
            v4u o;
#pragma unroll
            for (int e = 0; e < 4; ++e) o[e] = pk2(s[2 * e] * inv - bflo(a[e]), s[2 * e + 1] * inv - bfhi(a[e]));
            *(LAS v4u*)(Pl + t * LDT + c8) = o;
        }
        LDS_BAR();
        {
            bf16x8 a[4];
#pragma unroll
            for (int s = 0; s < 4; ++s) a[s] = ldfrag<false>(Pl, LDT, tb * 16, 32 * s, C.lane);
            bf16x8 fw[2][4];
#pragma unroll
            for (int s = 0; s < 4; ++s) fw[0][s] = ldfrag<true>(Wp, LDT, 0, 32 * s, C.lane);
#pragma unroll
            for (int db = 0; db < 8; ++db) {
                if (db + 1 < 8) {
#pragma unroll
                    for (int s = 0; s < 4; ++s) fw[(db + 1) & 1][s] = ldfrag<true>(Wp, LDT, (db + 1) * 16, 32 * s, C.lane); }
                __builtin_amdgcn_sched_barrier(0);
                f32x4 acc = {0.f, 0.f, 0.f, 0.f};
#pragma unroll
                for (int s = 0; s < 4; ++s) acc = mfma16(a[s], fw[db & 1][s], acc);
                const int d = db * 16 + c; const float sp = p.s_pool[l * 512 + g4 * 128 + d];
#pragma unroll
                for (int r = 0; r < 4; ++r) (p.MIX + (size_t)t0 * DM + MIX_POOL + g4 * 128)[(unsigned)((tb * 16 + 4 * g + r) * DM + d)] = (bf16)f2bf(acc[r] * sp);
                __builtin_amdgcn_sched_barrier(0);
            }
        }
        LDS_BAR();
        if (nx >= N) break;
        it = nx;
    }
}

__device__ __forceinline__ void phase_scan(const Ctx& C, const P& p) {
    const int gt = C.bid * NTHR + C.tid, NT = C.G * NTHR;
    constexpr int RQ = RD * RD / 4, NRET = BATCH * RH * RQ;
    constexpr int GQn = GDV * GDK / 4, NGLA = BATCH * GH * GQn;
    constexpr int NW = NGLA + NRET / 2;
    for (int w = gt; w < NW; w += NT) {
        if (w < NGLA) {
            const int chain = w / GQn, q = w % GQn, d = (q * 4) % GDK;
            f32x4 S = {0.f, 0.f, 0.f, 0.f};
#pragma unroll 8
            for (int n = 0; n < GNC; ++n) {
                const size_t base = ((size_t)(chain * GNC + n) * GQn + q) * 4;
                v2u o; o.x = pk2(S.x, S.y); o.y = pk2(S.z, S.w);
                *(v2u*)(p.sprev + base) = o;
                const v2u ub = *(const v2u*)(p.ugla + base); const f32x4 u = {bflo(ub.x), bfhi(ub.x), bflo(ub.y), bfhi(ub.y)};
                const f32x4 gg = *(const f32x4*)(p.gch + (size_t)(chain * GNC + n) * GDK + d);
                S = S * gg + u;
            }
        } else {
            const int it0 = (w - NGLA) * 2;
            const int chain = it0 / RQ, q = it0 % RQ, h = chain % RH;
            const float gc = __expf((float)RC * ret_log_g(h));
            f32x4 R0 = {0.f, 0.f, 0.f, 0.f}, R1 = R0;
#pragma unroll 8
            for (int n = 0; n < RNC; ++n) {
                const size_t base = ((size_t)(chain * RNC + n) * RQ + q) * 4;
                v4u o; o.x = pk2(R0.x, R0.y); o.y = pk2(R0.z, R0.w); o.z = pk2(R1.x, R1.y); o.w = pk2(R1.z, R1.w);
                *(v4u*)(p.rprev + base) = o;
                const v4u ub = *(const v4u*)(p.uret + base);
                R0 = R0 * gc + (f32x4){bflo(ub.x), bfhi(ub.x), bflo(ub.y), bfhi(ub.y)};
                R1 = R1 * gc + (f32x4){bflo(ub.z), bfhi(ub.z), bflo(ub.w), bfhi(ub.w)};
            }
        }
    }
}

#ifndef WGM_IN
#define WGM_IN 4
#define WGM_OUT 4
#define WGM_UP 4
#define WGM_DN 4
#endif
enum { PH_PRO = 0, PH_MODFIN = 1, PH_NORM1 = 2, PH_INPROJ = 3, PH_MIXA = 4, PH_SCAN = 5, PH_MIXB = 6, PH_OUTPROJ = 7, PH_NORM2 = 8, PH_UP = 9, PH_DOWN = 10, PH_FINAL = 11 };
struct Args { const float* in[15]; float* out; unsigned char* ws; int l_lo, l_hi, ph_lo, ph_hi, fused, pad; };

#define CAS __attribute__((address_space(4)))
__device__ __forceinline__ const CAS Args* kargs() { CAS void* k = (CAS void*)__builtin_amdgcn_kernarg_segment_ptr(); asm volatile("" : "+s"(k)); return (const CAS Args*)k; }
__device__ __forceinline__ P make_p(const Args& args, GAS unsigned char* ws) {
    P p;
    p.x = args.in[0]; p.c = args.in[1]; p.w_ada = args.in[2]; p.b_ada = args.in[3]; p.g_mix = args.in[4]; p.g_mlp = args.in[5]; p.w_in = args.in[6]; p.w_gate = args.in[7];
    p.b_gate = args.in[8]; p.w_pool = args.in[9]; p.s_pool = args.in[10]; p.w_out = args.in[11]; p.w_up = args.in[12]; p.w_down = args.in[13]; p.g_final = args.in[14];
    p.out = args.out;
    p.mod = (float*)(ws + WS_MOD); p.modp = (float*)(ws + WS_MODP); p.rot = (unsigned*)(ws + WS_COS); p.gch = (float*)(ws + WS_GCH); p.gb = (float*)(ws + WS_GB);
    p.X = (bf16*)(ws + WS_X); p.uret = (bf16*)(ws + WS_URET); p.ugla = (bf16*)(ws + WS_UGLA);
    p.win = (bf16*)(ws + WS_WIN); p.wout = (bf16*)(ws + WS_WOUT); p.wup = (bf16*)(ws + WS_WUP); p.wdn = (bf16*)(ws + WS_WDN);
    p.XN = (bf16*)(ws + WS_XN); p.Z = (bf16*)(ws + WS_Z); p.MIX = (bf16*)(ws + WS_MIX); p.H = (bf16*)(ws + WS_H); p.rprev = (bf16*)(ws + WS_RPREV); p.sprev = (bf16*)(ws + WS_SPREV);
    return p;
}
__device__ __forceinline__ Ctx make_ctx(LAS unsigned char* lds) {
    Ctx C; int tid = threadIdx.x; asm volatile("" : "+v"(tid));
    asm volatile("" : "+s"(lds));
    C.lds = lds; C.tid = tid; C.lane = tid & 63; C.wave = __builtin_amdgcn_readfirstlane(tid >> 6);
    int bid = blockIdx.x, G = gridDim.x; asm volatile("" : "+s"(bid), "+s"(G));
    C.bid = bid; C.G = G; return C;
}
__device__ __forceinline__ GAS unsigned char* launder_gptr(GAS unsigned char* q) { asm volatile("" : "+s"(q)); return q; }

__global__ void __launch_bounds__(NTHR, 2) fwd(Args args) {
    extern __shared__ __attribute__((aligned(16))) unsigned char lds_raw[];
    LAS unsigned char* const lds = (LAS unsigned char*)lds_raw;
    for (int u = threadIdx.x; u < (LDS_BYTES - LDSCTL_OFF) / 4; u += NTHR) ((LAS unsigned*)(lds + LDSCTL_OFF))[u] = 0u;
    __syncthreads();
    volatile LAS unsigned* MISC = (volatile LAS unsigned*)(lds + MISC_OFF);
    XcdBarrier bar; bar.bar = (unsigned*)(args.ws + WS_CTL) + CW_BAR; bar.x = 0; bar.st = nullptr;
    const bool fused = args.fused != 0;
    if (fused) bar = xcd_barrier_post((unsigned*)(args.ws + WS_CTL) + CW_BAR, MISC + 8);
#define GRID_BAR() do { if (fused) xcd_barrier(bar); } while (0)
    const int lo = args.ph_lo, hi = args.ph_hi;
#ifdef ONLY_PHASE
#define IN(k) (((ONLY_PHASE >> (k)) & 1) && lo <= (k) && (k) < hi)
#else
#define IN(k) (lo <= (k) && (k) < hi)
#endif
#ifndef PROBE_DUP
#define PROBE_DUP 0
#endif
#define REP(k) for (int rep_ = 0; rep_ < 1 + ((PROBE_DUP >> (k)) & 1); ++rep_)
#define PHASE_SETUP const Ctx C = make_ctx(lds); const P p = make_p(args, launder_gptr((GAS unsigned char*)args.ws))

    if (IN(PH_PRO)) REP(PH_PRO) { PHASE_SETUP; phase_prologue(C, p); GRID_BAR(); }
    if (IN(PH_MODFIN)) REP(PH_MODFIN) { PHASE_SETUP; phase_modfin(C, p); GRID_BAR(); }

    for (int l = args.l_lo; l < args.l_hi; ++l) {
        if (IN(PH_NORM1)) REP(PH_NORM1) { PHASE_SETUP; const float* modl = p.mod + (size_t)l * BATCH * NMOD;
            phase_norm_mod(C, p.X, p.g_mix + l * DM, modl + 0 * DM, modl + 1 * DM, p.XN); GRID_BAR(); }
        if (IN(PH_INPROJ)) REP(PH_INPROJ) { PHASE_SETUP;
            pg8::Gemm g{p.XN, p.win + (size_t)l * NZ * DM, M, NZ, DM}; pg8::StaticOrder S; S.init(M, NZ, C.G, C.bid, WGM_IN);
#if defined(PROBE_AMASK)
            const bool dummy_ = PROBE_DUP && rep_ == 0 && ((PROBE_DUP >> PH_INPROJ) & 1);
            if (dummy_) { g.amask = PROBE_AMASK; g.bmask = PROBE_BMASK; }
            pg8::EpiZ E{dummy_ ? (PROBE_BMASK == 12345 ? (bf16*)nullptr : p.H) : p.Z, p.rot};
            if (dummy_ && PROBE_BMASK == 12345) g.bmask = -1;
            if (dummy_ && PROBE_BMASK == 777) { g.bmask = -1; E.omask = ((size_t)1 << 24) - 8; }
            if (dummy_ && PROBE_BMASK == 778) { g.bmask = -1; E.omask = 0; }
#else
            pg8::EpiZ E{p.Z, p.rot};
#endif
            pg8::gemm_phase<pg8::EpiZ, pg8::StaticOrder, true, true, true, false, true>(C.lds, g, S, E);
            GRID_BAR();
        }
        if (IN(PH_MIXA)) REP(PH_MIXA) {
            REP(16) { PHASE_SETUP; asm volatile("; MARK_BEGIN phase_retA"); phase_retA(C, p); asm volatile("; MARK_END phase_retA"); }
            REP(17) { PHASE_SETUP; asm volatile("; MARK_BEGIN phase_glaA"); phase_glaA(C, p, l); asm volatile("; MARK_END phase_glaA"); }
            REP(18) { PHASE_SETUP; asm volatile("; MARK_BEGIN phase_pool"); phase_pool(C, p, l); asm volatile("; MARK_END phase_pool"); }
            GRID_BAR();
        }
        if (IN(PH_SCAN)) REP(PH_SCAN) { PHASE_SETUP; phase_scan(C, p); GRID_BAR(); }
        if (IN(PH_MIXB)) REP(PH_MIXB) {
            REP(19) { PHASE_SETUP; asm volatile("; MARK_BEGIN phase_retB"); phase_retB(C, p); asm volatile("; MARK_END phase_retB"); }
            REP(20) { PHASE_SETUP; asm volatile("; MARK_BEGIN phase_glaB"); phase_glaB(C, p, l); asm volatile("; MARK_END phase_glaB"); }
            GRID_BAR();
        }
        if (IN(PH_OUTPROJ)) REP(PH_OUTPROJ) { PHASE_SETUP; const float* modl = p.mod + (size_t)l * BATCH * NMOD;
            pg8::Gemm g{p.MIX, p.wout + (size_t)l * DM * DM, M, DM, DM}; pg8::StaticOrder S; S.init(M, DM, C.G, C.bid, WGM_OUT);
            pg8::EpiGateRes E{p.X, (PROBE_DUP && rep_ == 0 && ((PROBE_DUP >> PH_OUTPROJ) & 1)) ? p.Z : p.X, DM, modl + 2 * DM, NMOD, SEQ / 256};
            pg8::gemm_phase<pg8::EpiGateRes, pg8::StaticOrder, true, true, true, false, true>(C.lds, g, S, E);
            GRID_BAR();
        }
        if (IN(PH_NORM2)) REP(PH_NORM2) { PHASE_SETUP; const float* modl = p.mod + (size_t)l * BATCH * NMOD;
            phase_norm_mod(C, p.X, p.g_mlp + l * DM, modl + 3 * DM, modl + 4 * DM, p.XN); GRID_BAR(); }
        if (IN(PH_UP)) REP(PH_UP) { PHASE_SETUP;
            pg8::Gemm g{p.XN, p.wup + (size_t)l * DFF * DM, M, DFF, DM}; pg8::StaticOrder S; S.init(M, DFF, C.G, C.bid, WGM_UP);
            pg8::EpiRelu2 E{p.H, DFF};
            pg8::gemm_phase<pg8::EpiRelu2, pg8::StaticOrder, true, true, true, false, true>(C.lds, g, S, E);
            GRID_BAR();
        }
        if (IN(PH_DOWN)) REP(PH_DOWN) { PHASE_SETUP; const float* modl = p.mod + (size_t)l * BATCH * NMOD;
            pg8::Gemm g{p.H, p.wdn + (size_t)l * DM * DFF, M, DM, DFF}; pg8::StaticOrder S; S.init(M, DM, C.G, C.bid, WGM_DN);
            pg8::EpiGateRes E{p.X, (PROBE_DUP && rep_ == 0 && ((PROBE_DUP >> PH_DOWN) & 1)) ? p.Z : p.X, DM, modl + 5 * DM, NMOD, SEQ / 256};
            pg8::gemm_phase<pg8::EpiGateRes, pg8::StaticOrder, true, true, true, true>(C.lds, g, S, E);
            GRID_BAR();
        }
    }
    if (IN(PH_FINAL)) { PHASE_SETUP; phase_norm_final(C, p.X, p.g_final, p.out); }
#undef IN
#undef GRID_BAR
#undef PHASE_SETUP
#undef REP
}

#ifndef N_LAUNCH_MODE
#define N_LAUNCH_MODE 1
#endif
extern "C" void kernel_launch(void* const* d_in, const int* in_sizes, int n_in, void* d_out, int out_size, void* d_ws, size_t ws_size, hipStream_t stream) {
    static int grid = 0;
    if (grid == 0) {
        if (n_in != 15 || in_sizes[0] != M * DM || out_size != M * DM || ws_size < WS_END) { fprintf(stderr, "kernel_launch: unexpected shapes (n_in %d, in0 %d, out %d, ws %zu < %zu)\n", n_in, n_in > 0 ? in_sizes[0] : -1, out_size, ws_size, (size_t)WS_END); grid = -1; return; }
        int dev = 0, cus = 0, per_cu = 0;
        if (hipGetDevice(&dev) != hipSuccess || hipDeviceGetAttribute(&cus, hipDeviceAttributeMultiprocessorCount, dev) != hipSuccess) { grid = -1; return; }
        if (hipFuncSetAttribute((const void*)fwd, hipFuncAttributeMaxDynamicSharedMemorySize, LDS_BYTES) != hipSuccess) { fprintf(stderr, "kernel_launch: hipFuncSetAttribute failed\n"); grid = -1; return; }
        if (hipOccupancyMaxActiveBlocksPerMultiprocessor(&per_cu, (const void*)fwd, NTHR, LDS_BYTES) != hipSuccess || per_cu < 1) fprintf(stderr, "kernel_launch: occupancy query reports %d\n", per_cu);
        (void)hipGetLastError();
        grid = cus;
    }
    if (grid < 0) return;
    (void)hipMemsetAsync((char*)d_ws + WS_CTL, 0, CTL_ZERO_BYTES, stream);
    Args a{};
    for (int i = 0; i < 15; ++i) a.in[i] = (const float*)d_in[i];
    a.out = (float*)d_out; a.ws = (unsigned char*)d_ws; a.pad = 0;
#if N_LAUNCH_MODE == 1
    a.l_lo = 0; a.l_hi = DEPTH; a.ph_lo = 0; a.ph_hi = PH_FINAL + 1; a.fused = 1;
    hipLaunchKernelGGL(fwd, dim3(grid), dim3(NTHR), LDS_BYTES, stream, a);
#else
    a.fused = 0;
    a.l_lo = 0; a.l_hi = 0;
    a.ph_lo = PH_PRO; a.ph_hi = PH_PRO + 1; hipLaunchKernelGGL(fwd, dim3(grid), dim3(NTHR), LDS_BYTES, stream, a);
    a.ph_lo = PH_MODFIN; a.ph_hi = PH_MODFIN + 1; hipLaunchKernelGGL(fwd, dim3(grid), dim3(NTHR), LDS_BYTES, stream, a);
    for (int l = 0; l < DEPTH; ++l) for (int ph = PH_NORM1; ph <= PH_DOWN; ++ph) {
        a.l_lo = l; a.l_hi = l + 1; a.ph_lo = ph; a.ph_hi = ph + 1;
        hipLaunchKernelGGL(fwd, dim3(grid), dim3(NTHR), LDS_BYTES, stream, a);
    }
    a.l_lo = 0; a.l_hi = 0; a.ph_lo = PH_FINAL; a.ph_hi = PH_FINAL + 1;
    hipLaunchKernelGGL(fwd, dim3(grid), dim3(NTHR), LDS_BYTES, stream, a);
#endif
    const hipError_t le = hipPeekAtLastError();
    if (le != hipSuccess) fprintf(stderr, "kernel_launch: launch failed: %s\n", hipGetErrorName(le));
}
```
